# Optimizing an MI355X kernel written in HIP

```python
import jax
import jax.numpy as jnp
from jax import lax
import numpy as np

D_MODEL = 2048
BATCH = 4
SEQ = 4096
DEPTH = 1

EPS = 1e-6
ROPE_THETA = 10000.0
NEG = -1e30
BIG = 1e9

HG_HEADS = 8
HG_KDIM = 128
HG_VDIM = 128
HG_QK = HG_HEADS * HG_KDIM
HG_WIDTH = HG_HEADS * HG_VDIM
HG_CHUNK = 64

NSA_HEADS = 16
NSA_KV_GROUPS = 4
NSA_HEAD_DIM = 64
NSA_WIDTH = NSA_HEADS * NSA_HEAD_DIM
NSA_KV = NSA_KV_GROUPS * NSA_HEAD_DIM
CMP_BLOCK = 32
CMP_STRIDE = 16
CMP_HIDDEN = 256
SLC_BLOCK = 64
SLC_TOPK = 16
SLC_LOCAL = 2
WIN = 512
NSA_Q_BLOCK = 64

D_MIX = HG_WIDTH + NSA_WIDTH
IN_SIZES = (HG_QK, HG_QK, HG_WIDTH, HG_WIDTH, NSA_WIDTH, NSA_KV, NSA_KV, NSA_KV, NSA_KV, NSA_KV, NSA_KV, 3 * NSA_HEADS)
IN_COLS = sum(IN_SIZES)

MOE_GROUPS = 4
MOE_EXPERTS_PER_GROUP = 8
N_EXPERTS = MOE_GROUPS * MOE_EXPERTS_PER_GROUP
MOE_TOPK = 2
EXPERT_FF = 512
MOE_BLOCK = 128

kernel_name = 'hymba_hgrn2_nsa_hier_moe'


def rmsnorm(x, gain):
    xf = x.astype(jnp.float32)
    y = xf * lax.rsqrt(jnp.mean(xf * xf, axis=-1, keepdims=True) + EPS)
    return (y * gain.astype(jnp.float32)).astype(x.dtype)


def rope_tables(seq, dim):
    inv = 1.0 / (ROPE_THETA ** (jnp.arange(0, dim, 2, dtype=jnp.float32) / dim))
    ang = jnp.arange(seq, dtype=jnp.float32)[:, None] * inv[None, :]
    return jnp.cos(ang), jnp.sin(ang)


def apply_rope(x, cos, sin):
    x1, x2 = jnp.split(x.astype(jnp.float32), 2, axis=-1)
    c, s = cos[None, :, None, :], sin[None, :, None, :]
    return jnp.concatenate([x1 * c - x2 * s, x2 * c + x1 * s], axis=-1).astype(x.dtype)


def hgrn2_mixer(q, f_raw, i, g, lb, out_gain):
    B, S, _ = q.shape
    C = HG_CHUNK
    nc = S // C
    f = lb + (1.0 - lb) * jax.nn.sigmoid(f_raw.astype(jnp.float32))
    log_f = jnp.log(f)
    k = 1.0 - f

    def chunks(t, d):
        return t.astype(jnp.float32).reshape(B, nc, C, HG_HEADS, d).transpose(1, 0, 3, 2, 4)

    xs = (chunks(q, HG_KDIM) * HG_KDIM ** -0.5, chunks(k, HG_KDIM), chunks(i, HG_VDIM), chunks(log_f, HG_KDIM))
    causal = jnp.tril(jnp.ones((C, C), dtype=bool))[:, :, None]

    def step(state, inp):
        qb, kb, vb, lfb = inp
        bcum = jnp.cumsum(lfb, axis=2)
        diff = bcum[:, :, :, None, :] - bcum[:, :, None, :, :]
        decay = jnp.exp(jnp.where(causal, diff, -jnp.inf))
        scores = jnp.einsum('bhtk,bhtsk->bhts', qb, decay * kb[:, :, None, :, :])
        o = jnp.einsum('bhts,bhsv->bhtv', scores, vb) + jnp.einsum('bhtk,bhkv->bhtv', qb * jnp.exp(bcum), state)
        blast = bcum[:, :, -1:, :]
        state = jnp.exp(blast[:, :, 0, :])[..., None] * state + jnp.einsum('bhsk,bhsv->bhkv', kb * jnp.exp(blast - bcum), vb)
        return state, o

    s0 = jnp.zeros((B, HG_HEADS, HG_KDIM, HG_VDIM), jnp.float32)
    _, ys = lax.scan(step, s0, xs)
    o = ys.transpose(1, 0, 3, 2, 4).reshape(B, S, HG_HEADS, HG_VDIM)
    gate = jax.nn.silu(g.astype(jnp.float32)).reshape(B, S, HG_HEADS, HG_VDIM)
    o = rmsnorm(o, out_gain) * gate
    return o.reshape(B, S, HG_WIDTH).astype(q.dtype)


def compress_blocks(kv, pos, w1, w2):
    B, S, G, dk = kv.shape
    n_cmp = (S - CMP_BLOCK) // CMP_STRIDE + 1
    idx = np.arange(n_cmp)[:, None] * CMP_STRIDE + np.arange(CMP_BLOCK)[None, :]
    blk = kv[:, idx] + pos[None, None, :, None, :]
    flat = blk.transpose(0, 1, 3, 2, 4).reshape(B, n_cmp, G, CMP_BLOCK * dk)
    return jax.nn.gelu(flat @ w1) @ w2


def nsa_mixer(q, k_cmp, v_cmp, k_slc, v_slc, k_win, v_win, gate_raw,
              cmp_pos_k, cmp_w1_k, cmp_w2_k, cmp_pos_v, cmp_w1_v, cmp_w2_v, cos, sin):
    B, S, _ = q.shape
    H, G, dk = NSA_HEADS, NSA_KV_GROUPS, NSA_HEAD_DIM
    R = H // G
    Qb = NSA_Q_BLOCK
    scale = dk ** -0.5
    q = q.reshape(B, S, H, dk)
    q_rot = apply_rope(q, cos, sin)
    k_cmp, v_cmp, v_slc, v_win = [t.reshape(B, S, G, dk) for t in (k_cmp, v_cmp, v_slc, v_win)]
    k_slc = apply_rope(k_slc.reshape(B, S, G, dk), cos, sin)
    k_win = apply_rope(k_win.reshape(B, S, G, dk), cos, sin)

    kc = compress_blocks(k_cmp, cmp_pos_k, cmp_w1_k, cmp_w2_k)
    vc = compress_blocks(v_cmp, cmp_pos_v, cmp_w1_v, cmp_w2_v)
    n_cmp = kc.shape[1]
    cmp_end = jnp.arange(n_cmp) * CMP_STRIDE + CMP_BLOCK - 1

    n_slc = S // SLC_BLOCK
    topk = min(SLC_TOPK, n_slc)
    ci = np.arange(n_cmp)[:, None]
    sj = np.arange(n_slc)[None, :]
    overlap = (ci * CMP_STRIDE < (sj + 1) * SLC_BLOCK) & (ci * CMP_STRIDE + CMP_BLOCK > sj * SLC_BLOCK)
    agg = jnp.asarray(overlap, jnp.float32)
    kb = k_slc.reshape(B, n_slc, SLC_BLOCK, G, dk).transpose(0, 3, 1, 2, 4)
    vb = v_slc.reshape(B, n_slc, SLC_BLOCK, G, dk).transpose(0, 3, 1, 2, 4)
    blk_j = jnp.arange(n_slc)
    b_ix = jnp.arange(B)[:, None, None, None]
    g_ix = jnp.arange(G)[None, :, None, None]

    kw = jnp.pad(k_win, ((0, 0), (WIN, 0), (0, 0), (0, 0)))
    vw = jnp.pad(v_win, ((0, 0), (WIN, 0), (0, 0), (0, 0)))
    gates = jax.nn.sigmoid(gate_raw.astype(jnp.float32)).reshape(B, S, H, 3)

    def heads_by_group(t):
        return t.reshape(B, Qb, G, R, t.shape[-1]).transpose(0, 2, 3, 1, 4)

    def block(qs):
        t = qs + jnp.arange(Qb)
        qr = heads_by_group(lax.dynamic_slice_in_dim(q, qs, Qb, 1)).astype(jnp.float32)
        qo = heads_by_group(lax.dynamic_slice_in_dim(q_rot, qs, Qb, 1)).astype(jnp.float32)

        m_c = cmp_end[None, :] <= t[:, None]
        s_c = jnp.einsum('bgrqd,bcgd->bgrqc', qr, kc) * scale
        p_c = jax.nn.softmax(jnp.where(m_c, s_c, NEG), axis=-1) * m_c
        o_c = jnp.einsum('bgrqc,bcgd->bgrqd', p_c, vc)

        imp = jnp.einsum('bgrqc,cj->bgqj', p_c, agg)
        cur = t // SLC_BLOCK
        dj = cur[:, None] - blk_j[None, :]
        forced = (blk_j[None, :] == 0) | ((dj >= 0) & (dj < SLC_LOCAL))
        causal_blk = blk_j[None, :] * SLC_BLOCK <= t[:, None]
        imp = jnp.where(forced, BIG, jnp.where(causal_blk, imp, -BIG))
        _, idx = lax.top_k(imp, topk)
        kg = kb[b_ix, g_ix, idx]
        vg = vb[b_ix, g_ix, idx]
        pos = idx[..., None] * SLC_BLOCK + jnp.arange(SLC_BLOCK)
        m_s = (pos <= t[None, None, :, None, None])[:, :, None]
        s_s = jnp.einsum('bgrqd,bgqnld->bgrqnl', qo, kg) * scale
        s_s = jnp.where(m_s, s_s, NEG).reshape(B, G, R, Qb, topk * SLC_BLOCK)
        p_s = jax.nn.softmax(s_s, axis=-1).reshape(B, G, R, Qb, topk, SLC_BLOCK)
        o_s = jnp.einsum('bgrqnl,bgqnld->bgrqd', p_s, vg)

        kwin = lax.dynamic_slice_in_dim(kw, qs, WIN + Qb, 1)
        vwin = lax.dynamic_slice_in_dim(vw, qs, WIN + Qb, 1)
        kpos = qs - WIN + jnp.arange(WIN + Qb)
        dlt = t[:, None] - kpos[None, :]
        m_w = (dlt >= 0) & (dlt < WIN) & (kpos[None, :] >= 0)
        s_w = jnp.einsum('bgrqd,bkgd->bgrqk', qo, kwin) * scale
        p_w = jax.nn.softmax(jnp.where(m_w, s_w, NEG), axis=-1)
        o_w = jnp.einsum('bgrqk,bkgd->bgrqd', p_w, vwin)

        gq = heads_by_group(lax.dynamic_slice_in_dim(gates, qs, Qb, 1))
        o = gq[..., 0:1] * o_c + gq[..., 1:2] * o_s + gq[..., 2:3] * o_w
        return o.transpose(0, 3, 1, 2, 4).reshape(B, Qb, H * dk)

    out = lax.map(block, jnp.arange(S // Qb) * Qb)
    return out.transpose(1, 0, 2, 3).reshape(B, S, NSA_WIDTH).astype(q.dtype)


def hier_moe(x, w_group, b_group, w_router, b_router, w_gate, w_up, w_down):
    B, S, D = x.shape
    n_tok = B * S
    xt = x.reshape(n_tok, D)
    g_prob = jax.nn.softmax((xt @ w_group).astype(jnp.float32) + b_group.astype(jnp.float32), axis=-1)
    g_sel = jnp.argmax(g_prob, axis=-1)
    g_w = jnp.take_along_axis(g_prob, g_sel[:, None], axis=-1)
    e_logits = ((xt @ w_router).astype(jnp.float32) + b_router.astype(jnp.float32)).reshape(n_tok, MOE_GROUPS, MOE_EXPERTS_PER_GROUP)
    e_in = jnp.take_along_axis(e_logits, g_sel[:, None, None], axis=1)[:, 0]
    e_val, e_loc = lax.top_k(e_in, MOE_TOPK)
    e_w = jax.nn.softmax(e_val, axis=-1) * g_w
    e_id = g_sel[:, None] * MOE_EXPERTS_PER_GROUP + e_loc

    n_asg = n_tok * MOE_TOPK
    flat_e = e_id.reshape(n_asg).astype(jnp.int32)
    flat_t = jnp.repeat(jnp.arange(n_tok, dtype=jnp.int32), MOE_TOPK)
    flat_w = e_w.reshape(n_asg)
    order = jnp.argsort(flat_e)
    se, st, sw = flat_e[order], flat_t[order], flat_w[order]
    counts = jnp.bincount(flat_e, length=N_EXPERTS)
    start = jnp.cumsum(counts) - counts
    padded = (counts + MOE_BLOCK - 1) // MOE_BLOCK * MOE_BLOCK
    pend = jnp.cumsum(padded)
    pstart = pend - padded
    dest = pstart[se] + (jnp.arange(n_asg) - start[se])
    n_blocks = (n_asg + MOE_BLOCK - 1) // MOE_BLOCK + N_EXPERTS
    buf_tok = jnp.zeros((n_blocks * MOE_BLOCK,), jnp.int32).at[dest].set(st)
    buf_w = jnp.zeros((n_blocks * MOE_BLOCK,), jnp.float32).at[dest].set(sw)
    block_e = jnp.minimum(jnp.searchsorted(pend, jnp.arange(n_blocks) * MOE_BLOCK, side='right'), N_EXPERTS - 1)

    def expert_block(args):
        tok, w, e = args
        xb = xt[tok]
        hid = jax.nn.silu(xb @ w_gate[e]) * (xb @ w_up[e])
        return (hid @ w_down[e]) * w[:, None].astype(xb.dtype)

    ys = lax.map(expert_block, (buf_tok.reshape(n_blocks, MOE_BLOCK), buf_w.reshape(n_blocks, MOE_BLOCK), block_e))
    out = jnp.zeros((n_tok, D), x.dtype).at[buf_tok].add(ys.reshape(-1, D))
    return out.reshape(B, S, D)


def setup_inputs(seed: int = 0) -> dict:
    key = jax.random.key(seed)
    ks = jax.random.split(key, 24)
    L = DEPTH

    def nrm(k, shape, scale):
        return jax.random.normal(k, shape, jnp.float32) * scale

    return {
        'x': nrm(ks[0], (BATCH, SEQ, D_MODEL), 1.0),
        'attn_norm': 1.0 + nrm(ks[1], (L, D_MODEL), 0.02),
        'w_in': nrm(ks[2], (L, D_MODEL, IN_COLS), D_MODEL ** -0.5),
        'hg_lb_logits': nrm(ks[3], (L + 1, HG_QK), 0.5),
        'hg_out_norm': 1.0 + nrm(ks[4], (L, HG_VDIM), 0.02),
        'cmp_pos_k': nrm(ks[5], (L, CMP_BLOCK, NSA_HEAD_DIM), 0.1),
        'cmp_w1_k': nrm(ks[6], (L, CMP_BLOCK * NSA_HEAD_DIM, CMP_HIDDEN), (CMP_BLOCK * NSA_HEAD_DIM) ** -0.5),
        'cmp_w2_k': nrm(ks[7], (L, CMP_HIDDEN, NSA_HEAD_DIM), CMP_HIDDEN ** -0.5),
        'cmp_pos_v': nrm(ks[8], (L, CMP_BLOCK, NSA_HEAD_DIM), 0.1),
        'cmp_w1_v': nrm(ks[9], (L, CMP_BLOCK * NSA_HEAD_DIM, CMP_HIDDEN), (CMP_BLOCK * NSA_HEAD_DIM) ** -0.5),
        'cmp_w2_v': nrm(ks[10], (L, CMP_HIDDEN, NSA_HEAD_DIM), CMP_HIDDEN ** -0.5),
        'nsa_out_norm': 1.0 + nrm(ks[11], (L, NSA_WIDTH), 0.02),
        'w_out': nrm(ks[12], (L, D_MIX, D_MODEL), D_MIX ** -0.5),
        'ffn_norm': 1.0 + nrm(ks[13], (L, D_MODEL), 0.02),
        'moe_w_group': nrm(ks[14], (L, D_MODEL, MOE_GROUPS), D_MODEL ** -0.5),
        'moe_b_group': nrm(ks[15], (L, MOE_GROUPS), 0.01),
        'moe_w_router': nrm(ks[16], (L, D_MODEL, N_EXPERTS), D_MODEL ** -0.5),
        'moe_b_router': nrm(ks[17], (L, N_EXPERTS), 0.01),
        'moe_w_gate': nrm(ks[18], (L, N_EXPERTS, D_MODEL, EXPERT_FF), D_MODEL ** -0.5),
        'moe_w_up': nrm(ks[19], (L, N_EXPERTS, D_MODEL, EXPERT_FF), D_MODEL ** -0.5),
        'moe_w_down': nrm(ks[20], (L, N_EXPERTS, EXPERT_FF, D_MODEL), EXPERT_FF ** -0.5),
        'final_norm': 1.0 + nrm(ks[21], (D_MODEL,), 0.02),
    }


def reference(x, attn_norm, w_in, hg_lb_logits, hg_out_norm, cmp_pos_k, cmp_w1_k, cmp_w2_k,
              cmp_pos_v, cmp_w1_v, cmp_w2_v, nsa_out_norm, w_out, ffn_norm, moe_w_group, moe_b_group,
              moe_w_router, moe_b_router, moe_w_gate, moe_w_up, moe_w_down, final_norm):
    S = x.shape[1]
    cos, sin = rope_tables(S, NSA_HEAD_DIM)
    lower_bounds = jnp.cumsum(jax.nn.softmax(hg_lb_logits.astype(jnp.float32), axis=0), axis=0)
    split_at = [int(v) for v in np.cumsum(IN_SIZES)[:-1]]
    for l in range(DEPTH):
        h = rmsnorm(x, attn_norm[l])
        proj = jnp.einsum('bsd,de->bse', h, w_in[l])
        hq, hf, hi, hg, nq, kc, vc, ksl, vsl, kwn, vwn, gr = jnp.split(proj, split_at, axis=-1)
        y_hg = hgrn2_mixer(hq, hf, hi, hg, lower_bounds[l], hg_out_norm[l])
        y_nsa = nsa_mixer(nq, kc, vc, ksl, vsl, kwn, vwn, gr, cmp_pos_k[l], cmp_w1_k[l], cmp_w2_k[l],
                          cmp_pos_v[l], cmp_w1_v[l], cmp_w2_v[l], cos, sin)
        y_nsa = rmsnorm(y_nsa, nsa_out_norm[l])
        y = jnp.concatenate([y_hg.astype(x.dtype), y_nsa.astype(x.dtype)], axis=-1)
        x = x + jnp.einsum('bse,ed->bsd', y, w_out[l])
        x = x + hier_moe(rmsnorm(x, ffn_norm[l]), moe_w_group[l], moe_b_group[l], moe_w_router[l],
                         moe_b_router[l], moe_w_gate[l], moe_w_up[l], moe_w_down[l])
    return rmsnorm(x, final_norm)
```

```cpp
#include <hip/hip_runtime.h>
#include <cstdio>
#include <cstdint>
namespace pg8 {
#define PG8_LAS __attribute__((address_space(3)))
typedef unsigned short bf16_t;
typedef short bf16x8 __attribute__((ext_vector_type(8)));
typedef float f32x4 __attribute__((ext_vector_type(4)));
typedef unsigned u32x4 __attribute__((ext_vector_type(4)));
constexpr int BM = 256, BK = 64, HALF = 128, HTB = HALF * BK * 2  , STAGE_BYTES = 8 * HTB, NXCD = 8, WGM = 8;

__host__ __device__ __forceinline__ int lds_byte(int r, int c) { const int st = (r >> 4) * 2 + (c >> 5), rr = r & 15, cc = c & 31, ob = rr * 64 + cc * 2; return st * 1024 + (ob ^ (((ob >> 9) & 1) << 5)); }
__host__ __device__ __forceinline__ void stage_rc(int b, int& R, int& C) { const int st = b / 1024, sb = b % 1024, swz = sb ^ (((sb >> 9) & 1) << 5); R = (st >> 1) * 16 + swz / 64; C = (st & 1) * 32 + (swz % 64) / 2; }
__host__ __device__ __forceinline__ int perm32(int rho) { const int n = rho >> 4, i = rho & 15; return 8 * (i >> 2) + 4 * n + (i & 3); }

struct Unit { int pm, pn; const char* a; const char* b; };
struct Gemm { int K; int lda, ldb, kstepA; };

struct DenseOrder {
    int nM, nN, nwg, G, c; const char* A; const char* B; size_t tA, tB;
    __device__ __forceinline__ void init(const void* A_, const void* B_, int M, int N, int lda, int ldb, int G_, int c_) {
        nM = M / BM; nN = N / BM; nwg = nM * nN; G = G_; c = c_; A = (const char*)A_; B = (const char*)B_; tA = (size_t)BM * lda; tB = (size_t)BM * ldb; }
    __device__ __forceinline__ bool next(int i, Unit& u) const {
        const long L = (long)i * G + c; if (L >= nwg) return false;
        int wgid = (int)L; { const int q = nwg / NXCD, r = nwg % NXCD, xcd = wgid % NXCD, off = wgid / NXCD; wgid = (xcd < r ? xcd * (q + 1) : r * (q + 1) + (xcd - r) * q) + off; }
        const int nig = WGM * nN, gid = wgid / nig, fm = gid * WGM, gsz = (nM - fm) < WGM ? (nM - fm) : WGM;
        u.pm = fm + ((wgid % nig) % gsz); u.pn = (wgid % nig) / gsz; u.a = A + (size_t)u.pm * tA; u.b = B + (size_t)u.pn * tB; return true;
    }
    __device__ __forceinline__ void a_ready(const Unit&) const {}
    __device__ __forceinline__ void done(const Unit&) const {}
};

__device__ __forceinline__ unsigned cvt_pk_bf16(float lo, float hi) { unsigned r; asm volatile("v_cvt_pk_bf16_f32 %0, %1, %2" : "=v"(r) : "v"(lo), "v"(hi)); return r; }
__device__ __forceinline__ float gelu_tanh(float x) {
    const float u = 0.7978845608f * (x + 0.044715f * x * x * x);
    return x / (1.0f + __expf(-2.0f * u));
}
template <int ACT> struct EpiBf16 {
    static constexpr bool PERM = true, AFTER_DRAIN = false;
    bf16_t* O; int ldc; const float* bias;
    __device__ __forceinline__ void operator()(const f32x4 (&acc)[2][2][4][2], const Unit& u, int wr, int wc, int fr, int fq) const {
        const int row0 = u.pm * BM + wr * 64 + fr; const int col0 = u.pn * BM + wc * 32 + 8 * fq;
        f32x4 bv[2][2];
#pragma unroll
        for (int bj = 0; bj < 2; ++bj)
#pragma unroll
            for (int n = 0; n < 2; ++n) bv[bj][n] = bias ? *(const f32x4*)(bias + col0 + bj * HALF + 4 * n) : (f32x4){0.f, 0.f, 0.f, 0.f};
#pragma unroll
        for (int ai = 0; ai < 2; ++ai)
#pragma unroll
            for (int m = 0; m < 4; ++m) { bf16_t* rowp = O + (size_t)(row0 + ai * HALF + m * 16) * ldc + col0;
#pragma unroll
                for (int bj = 0; bj < 2; ++bj) { f32x4 v0 = acc[ai][bj][m][0] + bv[bj][0], v1 = acc[ai][bj][m][1] + bv[bj][1];
                    if (ACT == 2) {
#pragma unroll
                        for (int j = 0; j < 4; ++j) { v0[j] = gelu_tanh(v0[j]); v1[j] = gelu_tanh(v1[j]); } }
                    u32x4 w; w.x = cvt_pk_bf16(v0[0], v0[1]); w.y = cvt_pk_bf16(v0[2], v0[3]); w.z = cvt_pk_bf16(v1[0], v1[1]); w.w = cvt_pk_bf16(v1[2], v1[3]);
                    *(u32x4*)(rowp + bj * HALF) = w; } }
    }
};
struct EpiResF32 {
    static constexpr bool PERM = false, AFTER_DRAIN = false;
    const float* base; float* C; int ldc;
    __device__ __forceinline__ void operator()(const f32x4 (&acc)[2][2][4][2], const Unit& u, int wr, int wc, int fr, int fq) const {
        const int row0 = u.pm * BM + wr * 64 + fr, col0 = u.pn * BM + wc * 32 + 4 * fq;
#pragma unroll
        for (int ai = 0; ai < 2; ++ai)
#pragma unroll
            for (int m = 0; m < 4; ++m) { const size_t off = (size_t)(row0 + ai * HALF + m * 16) * ldc + col0;
#pragma unroll
                for (int bj = 0; bj < 2; ++bj)
#pragma unroll
                    for (int n = 0; n < 2; ++n) { const f32x4 bs = *(const f32x4*)(base + off + bj * HALF + n * 16); *(f32x4*)(C + off + bj * HALF + n * 16) = bs + acc[ai][bj][m][n]; } }
    }
};

template <class Epi, class Sched, bool ALIGN_EPI = false, bool SP2 = false>
__device__ __forceinline__ void gemm_phase(PG8_LAS unsigned char* lds, const Gemm g, const Sched& S, const Epi& E) {
    const int tid = threadIdx.x, wid = __builtin_amdgcn_readfirstlane(tid >> 6), lane = tid & 63, wr = wid >> 2, wc = wid & 3, fr = lane & 15, fq = lane >> 4;
    const int K = g.K, nt = K / BK;
    unsigned voffA[2], voffB[2];
#pragma unroll
    for (int i = 0; i < 2; ++i) { int R, C; stage_rc(tid * 16 + i * 8192, R, C); const int Rb = Epi::PERM ? ((R & ~31) + perm32(R & 31)) : R;
        voffA[i] = (unsigned)(R * g.lda + C * 2); voffB[i] = (unsigned)(Rb * g.ldb + C * 2); }
    const size_t kstepA = (size_t)g.kstepA, kstepB = (size_t)(BK * 2);
    const size_t hstepA = (size_t)HALF * g.lda, hstepB = (size_t)HALF * g.ldb;
    const unsigned ldsw = (unsigned)wid * 1024u;
    const int aoff = lds_byte(wr * 64 + fr, fq * 8), boff = lds_byte(wc * 32 + fr, fq * 8);
#define PG8_SA(b, h) (((b) * 2 + (h)) * HTB)
#define PG8_SB(b, h) ((4 + (b) * 2 + (h)) * HTB)
#define PG8_STAGE(bufoff, gbase, voff) do { _Pragma("unroll") for (int _i = 0; _i < 2; ++_i) \
        __builtin_amdgcn_global_load_lds((const unsigned*)((const char*)(gbase) + (voff)[_i]), (PG8_LAS unsigned*)(lds + (bufoff) + ldsw + _i * 8192), 16, 0, 0); } while (0)
#define PG8_LDA(dst, b, h) do { _Pragma("unroll") for (int m = 0; m < 4; ++m) _Pragma("unroll") for (int k = 0; k < 2; ++k) dst[m][k] = *(const PG8_LAS bf16x8*)(lds + PG8_SA(b, h) + aoff + m * 2048 + k * 1024); } while (0)
#define PG8_LDB(dst, b, h) do { _Pragma("unroll") for (int n = 0; n < 2; ++n) _Pragma("unroll") for (int k = 0; k < 2; ++k) dst[n][k] = *(const PG8_LAS bf16x8*)(lds + PG8_SB(b, h) + boff + n * 2048 + k * 1024); } while (0)
#define PG8_MMA(ai, bj, At, Bt) do { __builtin_amdgcn_s_setprio(1); _Pragma("unroll") for (int m = 0; m < 4; ++m) _Pragma("unroll") for (int n = 0; n < 2; ++n) _Pragma("unroll") for (int k = 0; k < 2; ++k) \
        acc[ai][bj][m][n] = __builtin_amdgcn_mfma_f32_16x16x32_bf16(Bt[n][k], At[m][k], acc[ai][bj][m][n], 0, 0, 0); __builtin_amdgcn_s_setprio(0); } while (0)
#define PG8_WAIT_V(n) asm volatile("s_waitcnt vmcnt(" #n ")" ::: "memory")
#define PG8_WAIT_L(n) asm volatile("s_waitcnt lgkmcnt(" #n ")" ::: "memory")
#define PG8_BAR __builtin_amdgcn_s_barrier()
#define PG8_SCHED __builtin_amdgcn_sched_barrier(0)
    Unit cur, nxt; int ui = 0;
    if (!S.next(0, cur)) return;
    f32x4 acc[2][2][4][2];
#pragma unroll
    for (int a = 0; a < 2; ++a)
#pragma unroll
        for (int b = 0; b < 2; ++b)
#pragma unroll
            for (int m = 0; m < 4; ++m)
#pragma unroll
                for (int n = 0; n < 2; ++n) acc[a][b][m][n] = (f32x4){0.f, 0.f, 0.f, 0.f};
    bf16x8 At[4][2], B0[2][2], B1[2][2];
    const char* cA = cur.a; const char* cB = cur.b;
    S.a_ready(cur);
    if constexpr (SP2) {
        PG8_STAGE(PG8_SB(0, 0), cB, voffB); PG8_STAGE(PG8_SB(0, 1), cB + hstepB, voffB); PG8_STAGE(PG8_SA(0, 0), cA, voffA); PG8_STAGE(PG8_SA(0, 1), cA + hstepA, voffA);
        if (wr == 1) PG8_BAR;
        PG8_WAIT_V(2); PG8_BAR;
        PG8_STAGE(PG8_SB(1, 0), cB + kstepB, voffB); PG8_STAGE(PG8_SA(1, 0), cA + kstepA, voffA); PG8_STAGE(PG8_SB(1, 1), cB + hstepB + kstepB, voffB);
        PG8_WAIT_V(6); PG8_BAR;
    } else {
        PG8_STAGE(PG8_SB(0, 0), cB, voffB); PG8_STAGE(PG8_SA(0, 0), cA, voffA); PG8_STAGE(PG8_SB(0, 1), cB + hstepB, voffB); PG8_STAGE(PG8_SA(0, 1), cA + hstepA, voffA);
        if (wr == 1) PG8_BAR;
        PG8_WAIT_V(4); PG8_BAR;
        PG8_STAGE(PG8_SB(1, 0), cB + kstepB, voffB); PG8_STAGE(PG8_SA(1, 0), cA + kstepA, voffA); PG8_STAGE(PG8_SB(1, 1), cB + hstepB + kstepB, voffB);
        PG8_WAIT_V(6); PG8_BAR;
    }
    for (;;) {
        const bool has_next = S.next(ui + 1, nxt);
        const char* nA = has_next ? nxt.a : cA; const char* nB = has_next ? nxt.b : cB;
        for (int t = 0; t < nt; t += 2) {
            const bool last = (t == nt - 2);
            const char* a1 = cA + (size_t)(t + 1) * kstepA;
            const char* a2 = last ? nA : cA + (size_t)(t + 2) * kstepA; const char* b2 = last ? nB : cB + (size_t)(t + 2) * kstepB;
            const char* a3 = a2 + kstepA; const char* b3 = b2 + kstepB;
            if (last && has_next) S.a_ready(nxt);
            if constexpr (SP2) {
            PG8_LDB(B0, 0, 0); PG8_LDB(B1, 0, 1); PG8_SCHED; PG8_LDA(At, 0, 0); PG8_STAGE(PG8_SA(1, 1), a1 + hstepA, voffA);
            PG8_WAIT_V(8); PG8_WAIT_L(0); PG8_BAR; PG8_MMA(0, 0, At, B0); PG8_MMA(0, 1, At, B1); PG8_BAR; PG8_SCHED;
            PG8_LDA(At, 0, 1); PG8_STAGE(PG8_SB(0, 0), b2, voffB); PG8_STAGE(PG8_SB(0, 1), b2 + hstepB, voffB); PG8_STAGE(PG8_SA(0, 0), a2, voffA);
            PG8_WAIT_V(8); PG8_WAIT_L(0); PG8_BAR; PG8_MMA(1, 0, At, B0); PG8_MMA(1, 1, At, B1); PG8_BAR; PG8_SCHED;
            PG8_LDB(B0, 1, 0); PG8_LDB(B1, 1, 1); PG8_SCHED; PG8_LDA(At, 1, 0); PG8_STAGE(PG8_SA(0, 1), a2 + hstepA, voffA);
            PG8_WAIT_V(8); PG8_WAIT_L(0); PG8_BAR; PG8_MMA(0, 0, At, B0); PG8_MMA(0, 1, At, B1); PG8_BAR; PG8_SCHED;
            PG8_LDA(At, 1, 1); PG8_STAGE(PG8_SB(1, 0), b3, voffB); PG8_STAGE(PG8_SB(1, 1), b3 + hstepB, voffB); PG8_STAGE(PG8_SA(1, 0), a3, voffA);
            PG8_WAIT_V(8); PG8_WAIT_L(0); PG8_BAR; PG8_MMA(1, 0, At, B0); PG8_MMA(1, 1, At, B1); PG8_BAR; PG8_SCHED;
            } else {
            PG8_LDB(B0, 0, 0); PG8_SCHED; PG8_LDA(At, 0, 0); PG8_STAGE(PG8_SA(1, 1), a1 + hstepA, voffA);
            PG8_WAIT_L(8); PG8_BAR; PG8_WAIT_L(0); PG8_MMA(0, 0, At, B0); PG8_BAR; PG8_SCHED;
            PG8_LDB(B1, 0, 1); PG8_STAGE(PG8_SB(0, 0), b2, voffB);
            PG8_BAR; PG8_WAIT_L(0); PG8_MMA(0, 1, At, B1); PG8_BAR;
            PG8_LDA(At, 0, 1); PG8_STAGE(PG8_SA(0, 0), a2, voffA);
            PG8_BAR; PG8_WAIT_L(0); PG8_MMA(1, 0, At, B0); PG8_BAR; PG8_SCHED;
            PG8_STAGE(PG8_SB(0, 1), b2 + hstepB, voffB);
            PG8_WAIT_V(6); PG8_BAR; PG8_MMA(1, 1, At, B1); PG8_BAR;
            PG8_LDB(B0, 1, 0); PG8_SCHED; PG8_LDA(At, 1, 0); PG8_STAGE(PG8_SA(0, 1), a2 + hstepA, voffA);
            PG8_WAIT_L(8); PG8_BAR; PG8_WAIT_L(0); PG8_MMA(0, 0, At, B0); PG8_BAR; PG8_SCHED;
            PG8_LDB(B1, 1, 1); PG8_STAGE(PG8_SB(1, 0), b3, voffB);
            PG8_BAR; PG8_WAIT_L(0); PG8_MMA(0, 1, At, B1); PG8_BAR;
            PG8_LDA(At, 1, 1); PG8_STAGE(PG8_SA(1, 0), a3, voffA);
            PG8_BAR; PG8_WAIT_L(0); PG8_MMA(1, 0, At, B0); PG8_BAR; PG8_SCHED;
            PG8_STAGE(PG8_SB(1, 1), b3 + hstepB, voffB);
            PG8_WAIT_V(6); PG8_BAR; PG8_MMA(1, 1, At, B1); PG8_BAR;
            }
        }
        if constexpr (ALIGN_EPI) { if (wr == 0) PG8_BAR; }
        if constexpr (!Epi::AFTER_DRAIN) { E(acc, cur, wr, wc, fr, fq); S.done(cur); }
        if (!has_next) break;
#pragma unroll
        for (int a = 0; a < 2; ++a)
#pragma unroll
            for (int b = 0; b < 2; ++b)
#pragma unroll
                for (int m = 0; m < 4; ++m)
#pragma unroll
                    for (int n = 0; n < 2; ++n) acc[a][b][m][n] = (f32x4){0.f, 0.f, 0.f, 0.f};
        cur = nxt; cA = nA; cB = nB; ++ui;
        if constexpr (ALIGN_EPI) { if (wr == 1) PG8_BAR; }
    }
    PG8_WAIT_V(0);
    if constexpr (!ALIGN_EPI) { if (wr == 0) PG8_BAR; }
    PG8_BAR;
    if constexpr (Epi::AFTER_DRAIN) { E.fused(acc, cur, wr, wc, fr, fq, lds, wid, lane); S.done(cur); }
#undef PG8_SA
#undef PG8_SB
#undef PG8_STAGE
#undef PG8_LDA
#undef PG8_LDB
#undef PG8_MMA
#undef PG8_WAIT_V
#undef PG8_WAIT_L
#undef PG8_BAR
#undef PG8_SCHED
}
}

#define GAS __attribute__((address_space(1)))
#define LAS __attribute__((address_space(3)))
typedef unsigned short bf16;
typedef unsigned v4u __attribute__((ext_vector_type(4)));
typedef unsigned v2u __attribute__((ext_vector_type(2)));
typedef float f32x4 __attribute__((ext_vector_type(4)));
typedef float f32x16 __attribute__((ext_vector_type(16)));
typedef short bf16x8 __attribute__((ext_vector_type(8)));
typedef short s16x4 __attribute__((ext_vector_type(4)));
typedef GAS unsigned gu32;
#define RLX_AGENT __ATOMIC_RELAXED, __HIP_MEMORY_SCOPE_AGENT
#define LDS_WAIT() asm volatile("s_waitcnt lgkmcnt(0)" ::: "memory")
#define VM_WAIT() asm volatile("s_waitcnt vmcnt(0)" ::: "memory")
__device__ __forceinline__ unsigned f2bf(float f) { unsigned u = __builtin_bit_cast(unsigned, f); return (u + 0x7fffu + ((u >> 16) & 1u)) >> 16; }
__device__ __forceinline__ unsigned pk2(float lo, float hi) { return f2bf(lo) | (f2bf(hi) << 16); }
__device__ __forceinline__ float bf2f(unsigned b) { return __builtin_bit_cast(float, b << 16); }
__device__ __forceinline__ float bflo(unsigned w) { return __builtin_bit_cast(float, w << 16); }
__device__ __forceinline__ float bfhi(unsigned w) { return __builtin_bit_cast(float, w & 0xffff0000u); }
__device__ __forceinline__ float wave_sum(float v) {
#pragma unroll
    for (int o = 1; o < 64; o <<= 1) v += __shfl_xor(v, o);
    return v;
}
__device__ __forceinline__ float wave_max(float v) {
#pragma unroll
    for (int o = 1; o < 64; o <<= 1) v = fmaxf(v, __shfl_xor(v, o));
    return v;
}

#define XB_TMO      128
#define XB_XCNT(j)  (256  + 64 * (j))
#define XB_XSUB(j)  (1280 + 64 * (j))
#define XB_XGEN(j)  (2304 + 64 * (j))
#define XB_TOP      3328
#define XB_TOPGEN   3392
#define XCD_BAR_WORDS 3456
#define XB_SPIN_CAP (1u << 18)

__device__ __forceinline__ unsigned xb_ld(unsigned* p)              { return __hip_atomic_load(p, __ATOMIC_RELAXED, __HIP_MEMORY_SCOPE_AGENT); }
__device__ __forceinline__ unsigned xb_add(unsigned* p, unsigned v) { return __hip_atomic_fetch_add(p, v, __ATOMIC_RELAXED, __HIP_MEMORY_SCOPE_AGENT); }
__device__ __forceinline__ unsigned xb_xcc_id() { return (unsigned)__builtin_amdgcn_s_getreg((3 << 11) | 20) & 0xFu; }
#define XB_SPIN(cond, bar) do { unsigned _sp = 0; while (cond) { __builtin_amdgcn_s_sleep(1); \
    if ((++_sp & 255u) == 0u) { if (xb_ld(&(bar)[XB_TMO])) break; if (_sp > XB_SPIN_CAP) { atomicAdd(&(bar)[XB_TMO], 1u); break; } } } } while (0)

struct XcdBarrier {
    unsigned* bar; unsigned x;
    volatile LAS unsigned* st;
};

__device__ __forceinline__ XcdBarrier xcd_barrier_post(unsigned* bar, volatile LAS unsigned* st) {
    XcdBarrier b; b.bar = bar; b.x = xb_xcc_id(); b.st = st;
    if (threadIdx.x == 0) (void)xb_add(&bar[XB_XCNT(b.x)], 1u);
    return b;
}
__device__ __forceinline__ void xcd_barrier_complete(unsigned* bar, unsigned x, unsigned& nloc, unsigned& nx) {
    const unsigned G = gridDim.x * gridDim.y * gridDim.z;
    unsigned sum, cnt, mine, sp = 0u;
    for (;;) {
        sum = 0u; cnt = 0u; mine = 0u;
#pragma unroll
        for (unsigned j = 0; j < 16; ++j) { const unsigned c = xb_ld(&bar[XB_XCNT(j)]); sum += c; cnt += (c > 0u) ? 1u : 0u; mine = (j == x) ? c : mine; }
        if (sum == G) break;
        __builtin_amdgcn_s_sleep(1);
        if ((++sp & 255u) == 0u) { if (xb_ld(&bar[XB_TMO])) break; if (sp > XB_SPIN_CAP) { atomicAdd(&bar[XB_TMO], 1u); break; } }
    }
    nloc = mine > 0u ? mine : 1u; nx = cnt > 0u ? cnt : 1u;
}

__device__ __forceinline__ void xcd_barrier(const XcdBarrier& b) {
    asm volatile("s_waitcnt vmcnt(0)" ::: "memory");
    __syncthreads();
    if (threadIdx.x == 0) {
        unsigned* bar = b.bar;
        __builtin_amdgcn_s_waitcnt(0);
        unsigned nloc = b.st[0], nx = b.st[1];
        if (nloc == 0u) { xcd_barrier_complete(bar, b.x, nloc, nx); b.st[0] = nloc; b.st[1] = nx; }
        const unsigned old = xb_add(&bar[XB_XSUB(b.x)], 1u);
        const unsigned gen = old / nloc;
        if (old + 1u == (gen + 1u) * nloc) {
            __builtin_amdgcn_fence(__ATOMIC_RELEASE, "agent");
            asm volatile("s_waitcnt vmcnt(0)" ::: "memory");
            const unsigned og = xb_add(&bar[XB_TOP], 1u);
            const unsigned tg = og / nx;
            if (og + 1u == (tg + 1u) * nx) xb_add(&bar[XB_TOPGEN], 1u);
            else XB_SPIN(xb_ld(&bar[XB_TOPGEN]) == tg, bar);
            __builtin_amdgcn_fence(__ATOMIC_ACQUIRE, "agent");
            xb_add(&bar[XB_XGEN(b.x)], 1u);
            asm volatile("s_waitcnt vmcnt(0)" ::: "memory");
        } else {
            XB_SPIN(xb_ld(&bar[XB_XGEN(b.x)]) == gen, bar);
            __builtin_amdgcn_fence(__ATOMIC_ACQUIRE, "agent");
            asm volatile("s_waitcnt vmcnt(0)" ::: "memory");
        }
    }
    __syncthreads();
}

constexpr int NWAVES = 8;
constexpr int NTOK = 16384, SEQ = 4096, DM = 2048;
constexpr int LDP = 6912;
constexpr int C_HQ = 0, C_HF = 1024, C_HI = 2048, C_HG = 3072, C_NQ = 4096, C_KC = 5120, C_VC = 5376, C_KS = 5632, C_VS = 5888, C_KW = 6144, C_VW = 6400, C_GR = 6656, IN_COLS = 6704;
constexpr float EPS = 1e-6f;
constexpr int MAXSLOT = 40960;
constexpr int MAXTILE = MAXSLOT / 256;

constexpr size_t MiB = 1u << 20;
constexpr size_t WS_CTL = 0, CTL_ZERO_BYTES = 1 * MiB;
constexpr size_t WS_SM = 1 * MiB;
constexpr size_t SM_LB = WS_SM + 0, SM_B1K = WS_SM + 4096, SM_B1V = WS_SM + 8192, SM_W2KT = WS_SM + 16384, SM_W2VT = WS_SM + 49152;
constexpr size_t SM_COS = WS_SM + 128 * 1024, SM_SIN = SM_COS + 512 * 1024;
constexpr size_t SM_W1KT = WS_SM + 2 * MiB, SM_W1VT = WS_SM + 3 * MiB;
constexpr size_t SM_EID = WS_SM + 5 * MiB, SM_EW = SM_EID + 128 * 1024, SM_TSLOT = SM_EW + 128 * 1024, SM_STOK = SM_TSLOT + 128 * 1024, SM_SW = SM_STOK + 160 * 1024, SM_TILEE = SM_SW + 160 * 1024;
constexpr size_t WS_KC = 11 * MiB, WS_VC = 11 * MiB + 512 * 1024;
constexpr size_t WS_WINT = 12 * MiB;
constexpr size_t WS_WOT = 39 * MiB;
constexpr size_t WS_B = 47 * MiB;
constexpr size_t WS_PROJ = 111 * MiB;
constexpr size_t WS_WGUT = WS_PROJ, WS_HIDM = WS_PROJ + 128 * MiB;
constexpr size_t WS_D = 328 * MiB;
constexpr size_t WS_OI = WS_D, WS_U = WS_D + 32 * MiB, WS_DD = WS_D + 96 * MiB, WS_ONSA = WS_D + 97 * MiB;
constexpr size_t WS_WDT = WS_D, WS_XG = WS_D + 64 * MiB;
constexpr size_t WS_END = WS_XG + 160 * MiB;
static_assert(WS_END <= 584 * MiB, "workspace map");
constexpr int CW_TMO = 0, CW_CODE = 1, CW_BAR = 4096, CW_CNT = 8192, CW_CUR = 8192 + 64;

constexpr int RING_OFF = 0, RING_BYTES = 131072;
constexpr int LDSCTL_OFF = RING_BYTES, MISC_OFF = LDSCTL_OFF + 320;
constexpr int LDS_BYTES = 147456;

struct Frame {
    LAS unsigned char* lds;
    volatile LAS unsigned* MISC;
    gu32* ctl;
    int tid, lane, wave, vcu, G;
    const float* in[22]; float* out; unsigned char* ws;
};
#define IN_X 0
#define IN_ATTN_NORM 1
#define IN_W_IN 2
#define IN_LB 3
#define IN_HG_NORM 4
#define IN_POS_K 5
#define IN_W1_K 6
#define IN_W2_K 7
#define IN_POS_V 8
#define IN_W1_V 9
#define IN_W2_V 10
#define IN_NSA_NORM 11
#define IN_W_OUT 12
#define IN_FFN_NORM 13
#define IN_W_GROUP 14
#define IN_B_GROUP 15
#define IN_W_ROUTER 16
#define IN_B_ROUTER 17
#define IN_W_GATE 18
#define IN_W_UP 19
#define IN_W_DOWN 20
#define IN_FINAL_NORM 21

__device__ __forceinline__ void transpose_item(const float* W, int ldn, int Nvalid, bf16* WT, int Kd, LAS float* scr, int k0, int n0, int lane) {
#pragma unroll 8
    for (int i = 0; i < 32; ++i) { const int kk = 2 * i + (lane >> 5); const int n = n0 + (lane & 31); scr[kk * 33 + (lane & 31)] = (n < Nvalid) ? W[(size_t)(k0 + kk) * ldn + n] : 0.f; }
    LDS_WAIT();
    const int c = lane & 7;
#pragma unroll
    for (int j = 0; j < 4; ++j) { const int n = (lane >> 3) + 8 * j; const LAS float* s = scr + (8 * c) * 33 + n;
        v4u o; o.x = pk2(s[0 * 33], s[1 * 33]); o.y = pk2(s[2 * 33], s[3 * 33]); o.z = pk2(s[4 * 33], s[5 * 33]); o.w = pk2(s[6 * 33], s[7 * 33]);
        *(v4u*)(WT + (size_t)(n0 + n) * Kd + k0 + 8 * c) = o; }
    LDS_WAIT();
}
__device__ __forceinline__ void rms_row_to_bf16(const float* xrow, const float* gain, bf16* orow, int lane) {
    const f32x4* xr = (const f32x4*)xrow + lane; const f32x4* gr = (const f32x4*)gain + lane;
    f32x4 v[8]; float s = 0.f;
#pragma unroll
    for (int j = 0; j < 8; ++j) { v[j] = xr[64 * j]; s += (v[j].x * v[j].x + v[j].y * v[j].y) + (v[j].z * v[j].z + v[j].w * v[j].w); }
    const float rstd = 1.0f / sqrtf(wave_sum(s) * (1.f / DM) + EPS);
    unsigned long long* o8 = (unsigned long long*)orow + lane;
#pragma unroll
    for (int j = 0; j < 8; ++j) { const f32x4 g = gr[64 * j]; o8[64 * j] = (unsigned long long)pk2(v[j].x * rstd * g.x, v[j].y * rstd * g.y) | ((unsigned long long)pk2(v[j].z * rstd * g.z, v[j].w * rstd * g.w) << 32); }
}
__device__ __forceinline__ void p0_prologue(Frame& F) {
    LAS float* scr = (LAS float*)(F.lds + RING_OFF + F.wave * 16384);
    const int gw = F.vcu * NWAVES + F.wave, NGW = F.G * NWAVES;
    constexpr int I_IN = 32 * (LDP / 32), I_O = 32 * 64, I_W1 = 32 * 8, I_W2 = 4 * 2;
    constexpr int NITEMS = I_IN + I_O + 2 * I_W1 + 2 * I_W2;
    for (int it = gw; it < NITEMS; it += NGW) {
        int r = it;
        if (r < I_IN) { const int nblk = LDP / 32; transpose_item(F.in[IN_W_IN], IN_COLS, IN_COLS, (bf16*)(F.ws + WS_WINT), DM, scr, 64 * (r / nblk), 32 * (r % nblk), F.lane); continue; } r -= I_IN;
        if (r < I_O) { transpose_item(F.in[IN_W_OUT], DM, DM, (bf16*)(F.ws + WS_WOT), DM, scr, 64 * (r / 64), 32 * (r % 64), F.lane); continue; } r -= I_O;
        if (r < I_W1) { transpose_item(F.in[IN_W1_K], 256, 256, (bf16*)(F.ws + SM_W1KT), 2048, scr, 64 * (r / 8), 32 * (r % 8), F.lane); continue; } r -= I_W1;
        if (r < I_W1) { transpose_item(F.in[IN_W1_V], 256, 256, (bf16*)(F.ws + SM_W1VT), 2048, scr, 64 * (r / 8), 32 * (r % 8), F.lane); continue; } r -= I_W1;
        if (r < I_W2) { transpose_item(F.in[IN_W2_K], 64, 64, (bf16*)(F.ws + SM_W2KT), 256, scr, 64 * (r / 2), 32 * (r % 2), F.lane); continue; } r -= I_W2;
        transpose_item(F.in[IN_W2_V], 64, 64, (bf16*)(F.ws + SM_W2VT), 256, scr, 64 * (r / 2), 32 * (r % 2), F.lane);
    }
    bf16* H = (bf16*)(F.ws + WS_B);
    for (int m = gw; m < NTOK; m += NGW) rms_row_to_bf16(F.in[IN_X] + (size_t)m * DM, F.in[IN_ATTN_NORM], H + (size_t)m * DM, F.lane);
    const int gt = F.vcu * (NWAVES * 64) + F.tid, NT = F.G * NWAVES * 64;
    float* LB = (float*)(F.ws + SM_LB);
    for (int i = gt; i < 1024; i += NT) { const float a0 = F.in[IN_LB][i], a1 = F.in[IN_LB][1024 + i]; LB[i] = 1.0f / (1.0f + expf(a1 - a0)); }
    float* COS = (float*)(F.ws + SM_COS); float* SIN = (float*)(F.ws + SM_SIN);
    for (int i = gt; i < SEQ * 32; i += NT) { const int t = i >> 5, k = i & 31;
        const double inv = exp2(-(double)k * (13.287712379549449 / 32.0));
        double rev = (double)t * inv * 0.15915494309189535; rev -= rint(rev);
        COS[i] = __builtin_amdgcn_cosf((float)rev); SIN[i] = __builtin_amdgcn_sinf((float)rev); }
    for (int it = gw; it < 8; it += NGW) { const int br = it >> 2, j = (it & 3) * 64 + F.lane; const float* pos = F.in[br ? IN_POS_V : IN_POS_K]; const float* w1 = F.in[br ? IN_W1_V : IN_W1_K];
        float a = 0.f; for (int k = 0; k < 2048; ++k) a += pos[k] * w1[(size_t)k * 256 + j];
        ((float*)(F.ws + (br ? SM_B1V : SM_B1K)))[j] = a; }
    unsigned* pad = (unsigned*)((bf16*)(F.ws + WS_PROJ) + (size_t)NTOK * LDP);
    for (int i = gt; i < 16 * LDP / 2; i += NT) pad[i] = 0u;
}

__device__ __forceinline__ void n2_rope_compress(Frame& F) {
    bf16* PROJ = (bf16*)(F.ws + WS_PROJ);
    const float* COS = (const float*)(F.ws + SM_COS); const float* SIN = (const float*)(F.ws + SM_SIN);
    const int gt = F.vcu * (NWAVES * 64) + F.tid, NT = F.G * NWAVES * 64;
    for (int idx = gt; idx < NTOK * 256; idx += NT) { const int i = idx & 31, g = (idx >> 5) & 3, ten = (idx >> 7) & 1, tok = idx >> 8, pos = tok & (SEQ - 1);
        bf16* p = PROJ + (size_t)tok * LDP + (ten ? C_KW : C_KS) + g * 64 + i;
        const float a = bf2f(p[0]), b = bf2f(p[32]), c = COS[pos * 32 + i], s = SIN[pos * 32 + i];
        p[0] = (bf16)f2bf(a * c - b * s); p[32] = (bf16)f2bf(b * c + a * s); }
    LAS float* scr = (LAS float*)(F.lds + RING_OFF + F.wave * 16384);
    const int gw = F.vcu * NWAVES + F.wave, NGW = F.G * NWAVES;
    for (int it = gw; it < 2 * 4080; it += NGW) {
        const int br = it / 4080; int r = it % 4080; const int b = r / 1020; r %= 1020; const int c = r >> 2, g = r & 3;
        const float* pos = F.in[br ? IN_POS_V : IN_POS_K]; const float* w1 = F.in[br ? IN_W1_V : IN_W1_K]; const float* w2 = F.in[br ? IN_W2_V : IN_W2_K];
        const bf16* src = PROJ + (size_t)(b * SEQ + c * 16) * LDP + (br ? C_VC : C_KC) + g * 64;
        for (int k = F.lane; k < 2048; k += 64) scr[k] = bf2f(src[(size_t)(k >> 6) * LDP + (k & 63)]) + pos[k];
        LDS_WAIT();
        float a0 = 0.f, a1 = 0.f, a2 = 0.f, a3 = 0.f;
        for (int k = 0; k < 2048; ++k) { const float f = scr[k]; const float* w = w1 + (size_t)k * 256 + F.lane; a0 += f * w[0]; a1 += f * w[64]; a2 += f * w[128]; a3 += f * w[192]; }
        scr[2048 + F.lane] = pg8::gelu_tanh(a0); scr[2048 + 64 + F.lane] = pg8::gelu_tanh(a1); scr[2048 + 128 + F.lane] = pg8::gelu_tanh(a2); scr[2048 + 192 + F.lane] = pg8::gelu_tanh(a3);
        LDS_WAIT();
        float o = 0.f;
        for (int j = 0; j < 256; ++j) o += scr[2048 + j] * w2[j * 64 + F.lane];
        ((bf16*)(F.ws + (br ? WS_VC : WS_KC)))[((size_t)(b * 256 + c) * 4 + g) * 64 + F.lane] = (bf16)f2bf(o);
        LDS_WAIT();
    }
}

__device__ __forceinline__ void n3_hgrn(Frame& F, int bh) {
    const int b = bh >> 3, h = bh & 7;
    const bf16* PROJ = (const bf16*)(F.ws + WS_PROJ); bf16* Y = (bf16*)(F.ws + WS_B);
    const float* LB = (const float*)(F.ws + SM_LB); const float* gain = F.in[IN_HG_NORM];
    LAS float* qs = (LAS float*)(F.lds); LAS float* fs = qs + 2048; LAS float* is = fs + 2048; LAS float* po = is + 2048;
    const int v = F.tid & 127, kq = F.tid >> 7;
    float S[32];
#pragma unroll
    for (int i = 0; i < 32; ++i) S[i] = 0.f;
    for (int blk = 0; blk < SEQ / 16; ++blk) {
        const int t0 = blk * 16;
        for (int e = F.tid; e < 2048; e += 512) { const int s = e >> 7, k = e & 127; const bf16* row = PROJ + (size_t)(b * SEQ + t0 + s) * LDP + h * 128 + k;
            const float lb = LB[h * 128 + k];
            qs[e] = bf2f(row[C_HQ]) * 0.08838834764831845f;
            fs[e] = lb + (1.0f - lb) / (1.0f + __expf(-bf2f(row[C_HF])));
            is[e] = bf2f(row[C_HI]); }
        __syncthreads();
        for (int s = 0; s < 16; ++s) { const float vv = is[s * 128 + v]; float acc = 0.f;
#pragma unroll
            for (int i = 0; i < 32; ++i) { const float f = fs[s * 128 + kq * 32 + i], q = qs[s * 128 + kq * 32 + i]; S[i] = f * S[i] + (1.0f - f) * vv; acc += q * S[i]; }
            po[(s * 4 + kq) * 128 + v] = acc; }
        __syncthreads();
#pragma unroll
        for (int ss = 0; ss < 2; ++ss) { const int s = F.wave * 2 + ss; const int tok = b * SEQ + t0 + s;
            const float o0 = (po[(s * 4 + 0) * 128 + F.lane] + po[(s * 4 + 1) * 128 + F.lane]) + (po[(s * 4 + 2) * 128 + F.lane] + po[(s * 4 + 3) * 128 + F.lane]);
            const float o1 = (po[(s * 4 + 0) * 128 + 64 + F.lane] + po[(s * 4 + 1) * 128 + 64 + F.lane]) + (po[(s * 4 + 2) * 128 + 64 + F.lane] + po[(s * 4 + 3) * 128 + 64 + F.lane]);
            const float rstd = 1.0f / sqrtf(wave_sum(o0 * o0 + o1 * o1) * (1.f / 128.f) + EPS);
            const bf16* grow = PROJ + (size_t)tok * LDP + C_HG + h * 128;
            const float g0 = bf2f(grow[F.lane]), g1 = bf2f(grow[64 + F.lane]);
            Y[(size_t)tok * DM + h * 128 + F.lane] = (bf16)f2bf(o0 * rstd * gain[F.lane] * (g0 / (1.0f + __expf(-g0))));
            Y[(size_t)tok * DM + h * 128 + 64 + F.lane] = (bf16)f2bf(o1 * rstd * gain[64 + F.lane] * (g1 / (1.0f + __expf(-g1)))); }
        __syncthreads();
    }
}
__device__ __forceinline__ float dot64(const LAS float* q, const bf16* krow) {
    const v4u* kr = (const v4u*)krow; float s = 0.f;
#pragma unroll
    for (int j = 0; j < 8; ++j) { const v4u w = kr[j]; const LAS float* qq = q + 8 * j;
        s += qq[0] * bflo(w.x) + qq[1] * bfhi(w.x) + qq[2] * bflo(w.y) + qq[3] * bfhi(w.y) + qq[4] * bflo(w.z) + qq[5] * bfhi(w.z) + qq[6] * bflo(w.w) + qq[7] * bfhi(w.w); }
    return s;
}
__device__ __forceinline__ void n3_attn_item(Frame& F, int item, LAS float* scr) {
    const bf16* PROJ = (const bf16*)(F.ws + WS_PROJ);
    const bf16* KC = (const bf16*)(F.ws + WS_KC); const bf16* VC = (const bf16*)(F.ws + WS_VC);
    const float* COS = (const float*)(F.ws + SM_COS); const float* SIN = (const float*)(F.ws + SM_SIN);
    float* ONSA = (float*)(F.ws + WS_ONSA);
    const int lane = F.lane;
    const int g = item & 3, tok = item >> 2, b = tok >> 12, t = tok & (SEQ - 1), cur = t >> 6;
    LAS float* qf = scr; LAS float* qr = scr + 256; LAS float* ps = scr + 512; LAS float* pc = scr + 768; LAS float* pb = scr + 1024;
    const bf16* qrow = PROJ + (size_t)tok * LDP + C_NQ + g * 256;
#pragma unroll
    for (int r = 0; r < 4; ++r) { const float q = bf2f(qrow[r * 64 + lane]); qf[r * 64 + lane] = q;
        const float qp = bf2f(qrow[r * 64 + (lane ^ 32)]); const float c = COS[t * 32 + (lane & 31)], s = SIN[t * 32 + (lane & 31)];
        qr[r * 64 + lane] = (lane < 32) ? (q * c - qp * s) : (q * c + qp * s); }
#pragma unroll
    for (int i = 0; i < 4; ++i) ps[i * 64 + lane] = 0.f;
    LDS_WAIT();
    const int nvalid = (t >= 31) ? ((t - 31) >> 4) + 1 : 0;
    float oc[4];
#pragma unroll
    for (int r = 0; r < 4; ++r) {
        float s[4]; float m = -3.0e38f;
#pragma unroll
        for (int i = 0; i < 4; ++i) { const int c = lane + 64 * i; s[i] = (c < nvalid) ? dot64(qf + r * 64, KC + ((size_t)(b * 256 + c) * 4 + g) * 64) * 0.125f : -3.0e38f; m = fmaxf(m, s[i]); }
        m = wave_max(m); float e[4]; float sum = 0.f;
#pragma unroll
        for (int i = 0; i < 4; ++i) { const int c = lane + 64 * i; e[i] = (c < nvalid) ? __expf(s[i] - m) : 0.f; sum += e[i]; }
        sum = wave_sum(sum); const float inv = (nvalid > 0) ? 1.0f / sum : 0.f;
#pragma unroll
        for (int i = 0; i < 4; ++i) { const float p = e[i] * inv; pc[i * 64 + lane] = p; ps[i * 64 + lane] += p; }
        LDS_WAIT();
        float a = 0.f;
        for (int c = 0; c < nvalid; ++c) a += pc[c] * bf2f(VC[((size_t)(b * 256 + c) * 4 + g) * 64 + lane]);
        oc[r] = a;
        LDS_WAIT();
    }
    float imp = 0.f;
#pragma unroll
    for (int dc = -1; dc <= 3; ++dc) { const int c = 4 * lane + dc; if (c >= 0 && c <= 254) imp += ps[c]; }
    const bool forced = (lane == 0) || (lane == cur) || (lane == cur - 1);
    const bool causal = lane <= cur;
    const float val = forced ? 1.0e9f : (causal ? imp : -1.0e9f);
    int rank = 0;
    for (int i = 0; i < 64; ++i) { const float vi = __shfl(val, i); rank += (vi > val || (vi == val && i < lane)) ? 1 : 0; }
    const unsigned long long selmask = __ballot((rank < 16) && causal);
    const bf16* gr = PROJ + (size_t)tok * LDP + C_GR + g * 12;
#pragma unroll
    for (int r = 0; r < 4; ++r) {
        float m = -3.0e38f, l = 0.f, acc = 0.f;
        unsigned long long mk = selmask;
        while (mk) { const int jb = __builtin_ctzll(mk); mk &= mk - 1;
            const int pos = jb * 64 + lane; const bool valid = pos <= t;
            const float s = valid ? dot64(qr + r * 64, PROJ + (size_t)(b * SEQ + pos) * LDP + C_KS + g * 64) * 0.125f : -3.0e38f;
            const float mn = fmaxf(m, wave_max(s)); const float alpha = __expf(m - mn); const float p = valid ? __expf(s - mn) : 0.f;
            l = l * alpha + wave_sum(p); acc *= alpha; pb[lane] = p; LDS_WAIT();
            const bf16* vb = PROJ + (size_t)(b * SEQ + jb * 64) * LDP + C_VS + g * 64 + lane;
            for (int k = 0; k < 64; ++k) acc += pb[k] * bf2f(vb[(size_t)k * LDP]);
            m = mn; LDS_WAIT(); }
        const float os = acc / l;
        m = -3.0e38f; l = 0.f; acc = 0.f;
        for (int i = 0; i < 8; ++i) { const int base = t - 511 + 64 * i; if (base + 63 < 0) continue;
            const int pos = base + lane; const bool valid = pos >= 0;
            const float s = valid ? dot64(qr + r * 64, PROJ + (size_t)(b * SEQ + pos) * LDP + C_KW + g * 64) * 0.125f : -3.0e38f;
            const float mn = fmaxf(m, wave_max(s)); const float alpha = __expf(m - mn); const float p = valid ? __expf(s - mn) : 0.f;
            l = l * alpha + wave_sum(p); acc *= alpha; pb[lane] = p; LDS_WAIT();
            const int k0 = base < 0 ? -base : 0;
            const bf16* vb = PROJ + (size_t)(b * SEQ) * LDP + C_VW + g * 64 + lane;
            for (int k = k0; k < 64; ++k) acc += pb[k] * bf2f(vb[(size_t)(base + k) * LDP]);
            m = mn; LDS_WAIT(); }
        const float ow = acc / l;
        const float gc = 1.0f / (1.0f + __expf(-bf2f(gr[r * 3 + 0]))), gs = 1.0f / (1.0f + __expf(-bf2f(gr[r * 3 + 1]))), gw = 1.0f / (1.0f + __expf(-bf2f(gr[r * 3 + 2])));
        ONSA[(size_t)tok * 1024 + (g * 4 + r) * 64 + lane] = gc * oc[r] + gs * os + gw * ow;
    }
}
__device__ __forceinline__ void n3_mixers(Frame& F) {
    if (F.vcu < 32) n3_hgrn(F, F.vcu);
    LAS float* scr = (LAS float*)(F.lds + RING_OFF + F.wave * 16384);
    const int gw = F.vcu * NWAVES + F.wave, NGW = F.G * NWAVES;
    for (int it = gw; it < NTOK * 4; it += NGW) n3_attn_item(F, it, scr);
}
__device__ __forceinline__ void n4_nsanorm(Frame& F) {
    const float* ONSA = (const float*)(F.ws + WS_ONSA); bf16* Y = (bf16*)(F.ws + WS_B); const float* gain = F.in[IN_NSA_NORM];
    const int gw = F.vcu * NWAVES + F.wave, NGW = F.G * NWAVES;
    for (int tok = gw; tok < NTOK; tok += NGW) {
        const f32x4* xr = (const f32x4*)(ONSA + (size_t)tok * 1024) + F.lane; const f32x4* gr = (const f32x4*)gain + F.lane;
        f32x4 v[4]; float s = 0.f;
#pragma unroll
        for (int j = 0; j < 4; ++j) { v[j] = xr[64 * j]; s += (v[j].x * v[j].x + v[j].y * v[j].y) + (v[j].z * v[j].z + v[j].w * v[j].w); }
        const float rstd = 1.0f / sqrtf(wave_sum(s) * (1.f / 1024.f) + EPS);
        unsigned long long* o8 = (unsigned long long*)(Y + (size_t)tok * DM + 1024) + F.lane;
#pragma unroll
        for (int j = 0; j < 4; ++j) { const f32x4 g = gr[64 * j]; o8[64 * j] = (unsigned long long)pk2(v[j].x * rstd * g.x, v[j].y * rstd * g.y) | ((unsigned long long)pk2(v[j].z * rstd * g.z, v[j].w * rstd * g.w) << 32); }
    }
}
__device__ __forceinline__ void p6_router(Frame& F) {
    const float* X2 = F.out; bf16* XN2 = (bf16*)(F.ws + WS_B);
    const float* gain = F.in[IN_FFN_NORM]; const float* wg = F.in[IN_W_GROUP]; const float* wr = F.in[IN_W_ROUTER];
    int* EID = (int*)(F.ws + SM_EID); float* EW = (float*)(F.ws + SM_EW);
    const int gw = F.vcu * NWAVES + F.wave, NGW = F.G * NWAVES;
    for (int tok = gw; tok < NTOK; tok += NGW) {
        const f32x4* xr = (const f32x4*)(X2 + (size_t)tok * DM) + F.lane; const f32x4* gr = (const f32x4*)gain + F.lane;
        f32x4 v[8]; float s = 0.f;
#pragma unroll
        for (int j = 0; j < 8; ++j) { v[j] = xr[64 * j]; s += (v[j].x * v[j].x + v[j].y * v[j].y) + (v[j].z * v[j].z + v[j].w * v[j].w); }
        const float rstd = 1.0f / sqrtf(wave_sum(s) * (1.f / DM) + EPS);
        unsigned long long* o8 = (unsigned long long*)(XN2 + (size_t)tok * DM) + F.lane;
#pragma unroll
        for (int j = 0; j < 8; ++j) { const f32x4 g = gr[64 * j]; v[j].x *= rstd * g.x; v[j].y *= rstd * g.y; v[j].z *= rstd * g.z; v[j].w *= rstd * g.w;
            o8[64 * j] = (unsigned long long)pk2(v[j].x, v[j].y) | ((unsigned long long)pk2(v[j].z, v[j].w) << 32); }
        LAS float* xs = (LAS float*)(F.lds + RING_OFF + F.wave * 16384);
#pragma unroll
        for (int j = 0; j < 8; ++j) *(LAS f32x4*)(xs + 4 * (64 * j + F.lane)) = v[j];
        LDS_WAIT();
        {
            const bool act = F.lane < 36; const float* wp = (F.lane < 4) ? (wg + F.lane) : (wr + (F.lane - 4)); const int st = (F.lane < 4) ? 4 : 32;
            float a0 = 0.f, a1 = 0.f, a2 = 0.f, a3 = 0.f;
            if (act) for (int d4 = 0; d4 < DM / 4; ++d4) { const f32x4 x4 = *(const LAS f32x4*)(xs + 4 * d4); const float* w = wp + (size_t)(4 * d4) * st;
                a0 += x4.x * w[0]; a1 += x4.y * w[st]; a2 += x4.z * w[2 * st]; a3 += x4.w * w[3 * st]; }
            xs[2048 + F.lane] = (a0 + a1) + (a2 + a3);
        }
        LDS_WAIT();
        float L[36];
#pragma unroll
        for (int o = 0; o < 36; ++o) L[o] = xs[2048 + o];
        if (F.lane == 0) {
            float gl[4];
#pragma unroll
            for (int i = 0; i < 4; ++i) gl[i] = L[i] + F.in[IN_B_GROUP][i];
            int gs = 0; float gm = gl[0];
#pragma unroll
            for (int i = 1; i < 4; ++i) if (gl[i] > gm) { gm = gl[i]; gs = i; }
            float den = 0.f;
#pragma unroll
            for (int i = 0; i < 4; ++i) den += expf(gl[i] - gm);
            const float gwt = 1.0f / den;
            float el[8];
#pragma unroll
            for (int i = 0; i < 8; ++i) { const float a = gs == 0 ? L[4 + i] : (gs == 1 ? L[12 + i] : (gs == 2 ? L[20 + i] : L[28 + i])); el[i] = a + F.in[IN_B_ROUTER][gs * 8 + i]; }
            int i1 = 0; float v1 = el[0];
#pragma unroll
            for (int i = 1; i < 8; ++i) if (el[i] > v1) { v1 = el[i]; i1 = i; }
            int i2 = -1; float v2 = -3.0e38f;
#pragma unroll
            for (int i = 0; i < 8; ++i) if (i != i1 && el[i] > v2) { v2 = el[i]; i2 = i; }
            const float e2 = expf(v2 - v1), w1 = gwt / (1.0f + e2), w2 = gwt * e2 / (1.0f + e2);
            const int id1 = gs * 8 + i1, id2 = gs * 8 + i2;
            EID[tok * 2] = id1; EID[tok * 2 + 1] = id2; EW[tok * 2] = w1; EW[tok * 2 + 1] = w2;
            __hip_atomic_fetch_add(F.ctl + CW_CNT + id1, 1u, RLX_AGENT); __hip_atomic_fetch_add(F.ctl + CW_CNT + id2, 1u, RLX_AGENT);
        }
        LDS_WAIT();
    }
}
__device__ __forceinline__ void p7_assign(Frame& F) {
    LAS int* pst = (LAS int*)(F.lds);
    if (F.tid == 0) { int acc = 0; for (int e = 0; e < 32; ++e) { const int c = (int)__hip_atomic_load(F.ctl + CW_CNT + e, RLX_AGENT); pst[e] = acc; pst[64 + e] = c; acc += ((c + 255) >> 8) << 8; } pst[32] = acc; }
    __syncthreads();
    int* TILEE = (int*)(F.ws + SM_TILEE);
    if (F.vcu == 0 && F.tid <= MAXTILE) { const int tl = F.tid; int e = -1;
        if (tl == MAXTILE) { TILEE[MAXTILE] = pst[32] >> 8; }
        else { for (int k = 0; k < 32; ++k) if ((pst[k] >> 8) <= tl && tl < (pst[k + 1] >> 8)) e = k; TILEE[tl] = e; } }
    if (F.vcu == 0 && F.tid < 64) { int* CNT = TILEE + 192; if (F.tid < 32) { CNT[F.tid] = pst[64 + F.tid]; CNT[32 + F.tid] = pst[F.tid]; } }
    const int* EID = (const int*)(F.ws + SM_EID); const float* EW = (const float*)(F.ws + SM_EW);
    int* TSLOT = (int*)(F.ws + SM_TSLOT); int* STOK = (int*)(F.ws + SM_STOK); float* SW = (float*)(F.ws + SM_SW);
    const bf16* XN2 = (const bf16*)(F.ws + WS_B); bf16* XG = (bf16*)(F.ws + WS_XG);
    const int gw = F.vcu * NWAVES + F.wave, NGW = F.G * NWAVES;
    for (int tok = gw; tok < NTOK; tok += NGW) {
        int slot = 0;
        if (F.lane < 2) { const int e = EID[tok * 2 + F.lane]; const int p = (int)__hip_atomic_fetch_add(F.ctl + CW_CUR + e, 1u, RLX_AGENT); slot = pst[e] + p;
            STOK[slot] = tok; SW[slot] = EW[tok * 2 + F.lane]; TSLOT[tok * 2 + F.lane] = slot; }
        const int s0 = __shfl(slot, 0), s1 = __shfl(slot, 1);
        const v4u* src = (const v4u*)(XN2 + (size_t)tok * DM) + F.lane; v4u* d0 = (v4u*)(XG + (size_t)s0 * DM) + F.lane; v4u* d1 = (v4u*)(XG + (size_t)s1 * DM) + F.lane;
#pragma unroll
        for (int j = 0; j < 4; ++j) { const v4u w = src[64 * j]; d0[64 * j] = w; d1[64 * j] = w; }
    }
}
__device__ __forceinline__ void n8_moe(Frame& F) {
    const int* TILEE = (const int*)(F.ws + SM_TILEE); const int* CNT = TILEE + 192; const float* SW = (const float*)(F.ws + SM_SW);
    bf16* XG = (bf16*)(F.ws + WS_XG);
    LAS float* xs = (LAS float*)(F.lds); LAS float* hs = xs + 16384;
    const int ntiles = TILEE[MAXTILE];
    for (int item = F.vcu; item < ntiles * 32; item += F.G) {
        const int e = TILEE[item >> 5], s0 = item * 8; const int nvalid = CNT[e] - (s0 - CNT[32 + e]);
        if (nvalid <= 0) continue;
        for (int idx = F.tid; idx < 16384; idx += 512) { const int r = idx >> 11, d = idx & 2047; xs[d * 8 + r] = (r < nvalid) ? bf2f(XG[(size_t)(s0 + r) * DM + d]) : 0.f; }
        __syncthreads();
        const float* Wg = F.in[IN_W_GATE] + (size_t)e * DM * 512 + F.tid; const float* Wu = F.in[IN_W_UP] + (size_t)e * DM * 512 + F.tid;
        float ag[8], au[8];
#pragma unroll
        for (int r = 0; r < 8; ++r) { ag[r] = 0.f; au[r] = 0.f; }
        for (int d = 0; d < DM; ++d) { const float wgv = Wg[(size_t)d * 512], wuv = Wu[(size_t)d * 512]; const f32x4 x0 = *(const LAS f32x4*)(xs + d * 8), x1 = *(const LAS f32x4*)(xs + d * 8 + 4);
#pragma unroll
            for (int r = 0; r < 4; ++r) { ag[r] += x0[r] * wgv; au[r] += x0[r] * wuv; ag[4 + r] += x1[r] * wgv; au[4 + r] += x1[r] * wuv; } }
#pragma unroll
        for (int r = 0; r < 8; ++r) hs[F.tid * 8 + r] = (ag[r] / (1.0f + __expf(-ag[r]))) * au[r];
        __syncthreads();
        const float* Wd = F.in[IN_W_DOWN] + (size_t)e * 512 * DM + F.tid;
        float acc[4][8];
#pragma unroll
        for (int i = 0; i < 4; ++i)
#pragma unroll
            for (int r = 0; r < 8; ++r) acc[i][r] = 0.f;
        for (int j = 0; j < 512; ++j) { const f32x4 h0 = *(const LAS f32x4*)(hs + j * 8), h1 = *(const LAS f32x4*)(hs + j * 8 + 4);
#pragma unroll
            for (int i = 0; i < 4; ++i) { const float w = Wd[(size_t)j * DM + 512 * i];
#pragma unroll
                for (int r = 0; r < 4; ++r) { acc[i][r] += h0[r] * w; acc[i][4 + r] += h1[r] * w; } } }
#pragma unroll
        for (int r = 0; r < 8; ++r) if (r < nvalid) { const float w = SW[s0 + r];
#pragma unroll
            for (int i = 0; i < 4; ++i) XG[(size_t)(s0 + r) * DM + F.tid + 512 * i] = (bf16)f2bf(acc[i][r] * w); }
        __syncthreads();
    }
}
__device__ __forceinline__ void p10_final(Frame& F) {
    const int* TSLOT = (const int*)(F.ws + SM_TSLOT); const bf16* YD = (const bf16*)(F.ws + WS_XG); const float* gain = F.in[IN_FINAL_NORM];
    const int gw = F.vcu * NWAVES + F.wave, NGW = F.G * NWAVES;
    for (int tok = gw; tok < NTOK; tok += NGW) {
        const int s0 = TSLOT[tok * 2], s1 = TSLOT[tok * 2 + 1];
        f32x4* xr = (f32x4*)(F.out + (size_t)tok * DM) + F.lane; const f32x4* gr = (const f32x4*)gain + F.lane;
        const v2u* y0 = (const v2u*)(YD + (size_t)s0 * DM) + F.lane; const v2u* y1 = (const v2u*)(YD + (size_t)s1 * DM) + F.lane;
        f32x4 v[8]; float s = 0.f;
#pragma unroll
        for (int j = 0; j < 8; ++j) { v[j] = xr[64 * j]; const v2u a = y0[64 * j], b = y1[64 * j];
            v[j].x = (v[j].x + bflo(a.x)) + bflo(b.x); v[j].y = (v[j].y + bfhi(a.x)) + bfhi(b.x); v[j].z = (v[j].z + bflo(a.y)) + bflo(b.y); v[j].w = (v[j].w + bfhi(a.y)) + bfhi(b.y);
            s += (v[j].x * v[j].x + v[j].y * v[j].y) + (v[j].z * v[j].z + v[j].w * v[j].w); }
        const float rstd = 1.0f / sqrtf(wave_sum(s) * (1.f / DM) + EPS);
#pragma unroll
        for (int j = 0; j < 8; ++j) { const f32x4 g = gr[64 * j]; xr[64 * j] = (f32x4){v[j].x * rstd * g.x, v[j].y * rstd * g.y, v[j].z * rstd * g.z, v[j].w * rstd * g.w}; }
    }
}

constexpr int N_PHASES = 10;
#ifndef MK_ONE_LAUNCH
#define MK_ONE_LAUNCH 1
#endif
struct Args { const float* in[22]; float* out; unsigned char* ws; int ph_lo, ph_hi; };
__global__ void __launch_bounds__(NWAVES * 64, 2) fwd(Args args) {
    extern __shared__ __attribute__((aligned(16))) unsigned char lds[];
    Frame F;
    F.lds = (LAS unsigned char*)lds;
    F.MISC = (volatile LAS unsigned*)(F.lds + MISC_OFF);
    F.tid = threadIdx.x; F.lane = F.tid & 63; F.wave = __builtin_amdgcn_readfirstlane(F.tid >> 6);
    F.G = gridDim.x; { const int bx = blockIdx.x; F.vcu = (F.G % 8 == 0) ? (bx % 8) * (F.G / 8) + bx / 8 : bx; }
#pragma unroll
    for (int i = 0; i < 22; ++i) F.in[i] = args.in[i];
    F.out = args.out; F.ws = args.ws; F.ctl = (gu32*)(args.ws + WS_CTL);
    for (int u = F.tid; u < (LDS_BYTES - LDSCTL_OFF) / 4; u += NWAVES * 64) ((LAS unsigned*)(F.lds + LDSCTL_OFF))[u] = 0u;
    __syncthreads();
    const int lo = args.ph_lo, hi = args.ph_hi;
    const bool multi = (hi - lo) > 1;
    XcdBarrier bar; bar.bar = (unsigned*)(F.ctl + CW_BAR); bar.x = 0; bar.st = nullptr;
    if (multi) bar = xcd_barrier_post((unsigned*)(F.ctl + CW_BAR), F.MISC + 8);
#ifndef PHMASK
#define PHMASK 0xFFFF
#endif
#define IN(k) (((PHMASK >> (k)) & 1) && lo <= (k) && (k) < hi)
#define SEAM(k) do { if (IN(k) && IN((k) + 1)) xcd_barrier(bar); } while (0)
    if (IN(0)) { p0_prologue(F); } SEAM(0);
    if (IN(1)) {
        pg8::Gemm g{DM, DM * 2, DM * 2, 128}; pg8::DenseOrder S; S.init(F.ws + WS_B, F.ws + WS_WINT, NTOK, LDP, DM * 2, DM * 2, F.G, (int)blockIdx.x);
        pg8::EpiBf16<0> E{(pg8::bf16_t*)(F.ws + WS_PROJ), LDP, nullptr};
        pg8::gemm_phase<pg8::EpiBf16<0>, pg8::DenseOrder, true, true>(F.lds + RING_OFF, g, S, E);
    } SEAM(1);
    if (IN(2)) { n2_rope_compress(F); } SEAM(2);
    if (IN(3)) { n3_mixers(F); } SEAM(3);
    if (IN(4)) { n4_nsanorm(F); } SEAM(4);
    if (IN(5)) {
        pg8::Gemm g{DM, DM * 2, DM * 2, 128}; pg8::DenseOrder S; S.init(F.ws + WS_B, F.ws + WS_WOT, NTOK, DM, DM * 2, DM * 2, F.G, (int)blockIdx.x);
        pg8::EpiResF32 E{F.in[IN_X], F.out, DM};
        pg8::gemm_phase<pg8::EpiResF32, pg8::DenseOrder, true, true>(F.lds + RING_OFF, g, S, E);
    } SEAM(5);
    if (IN(6)) { p6_router(F); } SEAM(6);
    if (IN(7)) { p7_assign(F); } SEAM(7);
    if (IN(8)) { n8_moe(F); } SEAM(8);
    if (IN(9)) { p10_final(F); }
#undef IN
#undef SEAM
}

extern "C" void kernel_launch(void* const* d_in, const int* in_sizes, int n_in, void* d_out, int out_size, void* d_ws, size_t ws_size, hipStream_t stream) {
    static int grid = 0;
    if (grid == 0) {
        if (n_in != 22 || out_size != NTOK * DM || ws_size < WS_END) { fprintf(stderr, "kernel_launch: unexpected shapes (n_in %d, out %d, ws %zu < %zu)\n", n_in, out_size, ws_size, (size_t)WS_END); grid = -1; return; }
        int dev = 0, cus = 0, per_cu = 0;
        if (hipGetDevice(&dev) != hipSuccess || hipDeviceGetAttribute(&cus, hipDeviceAttributeMultiprocessorCount, dev) != hipSuccess) { grid = -1; return; }
        if (hipFuncSetAttribute((const void*)fwd, hipFuncAttributeMaxDynamicSharedMemorySize, LDS_BYTES) != hipSuccess) { fprintf(stderr, "kernel_launch: hipFuncSetAttribute failed\n"); grid = -1; return; }
        if (hipOccupancyMaxActiveBlocksPerMultiprocessor(&per_cu, (const void*)fwd, NWAVES * 64, LDS_BYTES) != hipSuccess || per_cu < 1) { fprintf(stderr, "kernel_launch: occupancy query says %d\n", per_cu); }
        (void)hipGetLastError();
        grid = cus;
    }
    if (grid < 0) return;
    (void)hipMemsetAsync((char*)d_ws + WS_CTL, 0, CTL_ZERO_BYTES, stream);
    Args a{};
    for (int i = 0; i < 22; ++i) a.in[i] = (const float*)d_in[i];
    a.out = (float*)d_out; a.ws = (unsigned char*)d_ws;
#if MK_ONE_LAUNCH
    a.ph_lo = 0; a.ph_hi = N_PHASES;
    hipLaunchKernelGGL(fwd, dim3(grid), dim3(NWAVES * 64), LDS_BYTES, stream, a);
#else
    for (int p = 0; p < N_PHASES; ++p) { a.ph_lo = p; a.ph_hi = p + 1; hipLaunchKernelGGL(fwd, dim3(grid), dim3(NWAVES * 64), LDS_BYTES, stream, a); }
#endif
}
```

```cpp
#include <hip/hip_runtime.h>
#include <cstdio>
#include <cstdint>
namespace pg8 {
#define PG8_LAS __attribute__((address_space(3)))
typedef unsigned short bf16_t;
typedef short bf16x8 __attribute__((ext_vector_type(8)));
typedef float f32x4 __attribute__((ext_vector_type(4)));
typedef unsigned u32x4 __attribute__((ext_vector_type(4)));
constexpr int BM = 256, BK = 64, HALF = 128, HTB = HALF * BK * 2  , STAGE_BYTES = 8 * HTB, NXCD = 8, WGM = 8;

__host__ __device__ __forceinline__ int lds_byte(int r, int c) { const int st = (r >> 4) * 2 + (c >> 5), rr = r & 15, cc = c & 31, ob = rr * 64 + cc * 2; return st * 1024 + (ob ^ (((ob >> 9) & 1) << 5)); }
__host__ __device__ __forceinline__ void stage_rc(int b, int& R, int& C) { const int st = b / 1024, sb = b % 1024, swz = sb ^ (((sb >> 9) & 1) << 5); R = (st >> 1) * 16 + swz / 64; C = (st & 1) * 32 + (swz % 64) / 2; }
__host__ __device__ __forceinline__ int perm32(int rho) { const int n = rho >> 4, i = rho & 15; return 8 * (i >> 2) + 4 * n + (i & 3); }

typedef unsigned u32x2 __attribute__((ext_vector_type(2)));
struct Unit { int pm, pn; const char* a; const char* b; };
struct Gemm { int K; int lda, ldb, kstepA; };

struct DenseOrder {
    int nM, nN, nwg, G, c; const char* A; const char* B; size_t tA, tB;
    __device__ __forceinline__ void init(const void* A_, const void* B_, int M, int N, int lda, int ldb, int G_, int c_) {
        nM = M / BM; nN = N / BM; nwg = nM * nN; G = G_; c = c_; A = (const char*)A_; B = (const char*)B_; tA = (size_t)BM * lda; tB = (size_t)BM * ldb; }
    __device__ __forceinline__ bool next(int i, Unit& u) const {
        const long L = (long)i * G + c; if (L >= nwg) return false;
        int wgid = (int)L; { const int q = nwg / NXCD, r = nwg % NXCD, xcd = wgid % NXCD, off = wgid / NXCD; wgid = (xcd < r ? xcd * (q + 1) : r * (q + 1) + (xcd - r) * q) + off; }
        const int nig = WGM * nN, gid = wgid / nig, fm = gid * WGM, gsz = (nM - fm) < WGM ? (nM - fm) : WGM;
        u.pm = fm + ((wgid % nig) % gsz); u.pn = (wgid % nig) / gsz; u.a = A + (size_t)u.pm * tA; u.b = B + (size_t)u.pn * tB; return true;
    }
    __device__ __forceinline__ void a_ready(const Unit&) const {}
    __device__ __forceinline__ void done(const Unit&) const {}
};

__device__ __forceinline__ unsigned cvt_pk_bf16(float lo, float hi) { unsigned r; asm volatile("v_cvt_pk_bf16_f32 %0, %1, %2" : "=v"(r) : "v"(lo), "v"(hi)); return r; }
__device__ __forceinline__ float gelu_tanh(float x) {
    const float u = 0.7978845608f * (x + 0.044715f * x * x * x);
    return x / (1.0f + __expf(-2.0f * u));
}
template <int ACT> struct EpiBf16 {
    static constexpr bool PERM = true, AFTER_DRAIN = false;
    bf16_t* O; int ldc; const float* bias;
    __device__ __forceinline__ void operator()(const f32x4 (&acc)[2][2][4][2], const Unit& u, int wr, int wc, int fr, int fq) const {
        const int row0 = u.pm * BM + wr * 64 + fr; const int col0 = u.pn * BM + wc * 32 + 8 * fq;
        f32x4 bv[2][2];
#pragma unroll
        for (int bj = 0; bj < 2; ++bj)
#pragma unroll
            for (int n = 0; n < 2; ++n) bv[bj][n] = bias ? *(const f32x4*)(bias + col0 + bj * HALF + 4 * n) : (f32x4){0.f, 0.f, 0.f, 0.f};
#pragma unroll
        for (int ai = 0; ai < 2; ++ai)
#pragma unroll
            for (int m = 0; m < 4; ++m) { bf16_t* rowp = O + (size_t)(row0 + ai * HALF + m * 16) * ldc + col0;
#pragma unroll
                for (int bj = 0; bj < 2; ++bj) { f32x4 v0 = acc[ai][bj][m][0] + bv[bj][0], v1 = acc[ai][bj][m][1] + bv[bj][1];
                    if (ACT == 2) {
#pragma unroll
                        for (int j = 0; j < 4; ++j) { v0[j] = gelu_tanh(v0[j]); v1[j] = gelu_tanh(v1[j]); } }
                    u32x4 w; w.x = cvt_pk_bf16(v0[0], v0[1]); w.y = cvt_pk_bf16(v0[2], v0[3]); w.z = cvt_pk_bf16(v1[0], v1[1]); w.w = cvt_pk_bf16(v1[2], v1[3]);
                    *(u32x4*)(rowp + bj * HALF) = w; } }
    }
};
struct EpiResF32 {
    static constexpr bool PERM = false, AFTER_DRAIN = false;
    const float* base; float* C; int ldc;
    __device__ __forceinline__ void operator()(const f32x4 (&acc)[2][2][4][2], const Unit& u, int wr, int wc, int fr, int fq) const {
        const int row0 = u.pm * BM + wr * 64 + fr, col0 = u.pn * BM + wc * 32 + 4 * fq;
#pragma unroll
        for (int ai = 0; ai < 2; ++ai)
#pragma unroll
            for (int m = 0; m < 4; ++m) { const size_t off = (size_t)(row0 + ai * HALF + m * 16) * ldc + col0;
#pragma unroll
                for (int bj = 0; bj < 2; ++bj)
#pragma unroll
                    for (int n = 0; n < 2; ++n) { const f32x4 bs = *(const f32x4*)(base + off + bj * HALF + n * 16); *(f32x4*)(C + off + bj * HALF + n * 16) = bs + acc[ai][bj][m][n]; } }
    }
};


struct MoeOrder {
    int NC, G, c, nunits; const int* tile_e; const char* A; const char* B; size_t tA, tE, tN;
    __device__ __forceinline__ void init(const void* A_, const void* B_, const int* tile_e_, int ntiles, int NC_, int lda, int ldb, int rows_per_expert, int G_, int c_) {
        NC = NC_; G = G_; c = c_; nunits = ntiles * NC_; tile_e = tile_e_; A = (const char*)A_; B = (const char*)B_; tA = (size_t)BM * lda; tE = (size_t)rows_per_expert * ldb; tN = (size_t)BM * ldb; }
    __device__ __forceinline__ bool next(int i, Unit& u) const {
        const int L = i * G + c; if (L >= nunits) return false;
        u.pm = L / NC; u.pn = L % NC; const int e = tile_e[u.pm]; u.a = A + (size_t)u.pm * tA; u.b = B + (size_t)e * tE + (size_t)u.pn * tN; return true;
    }
    __device__ __forceinline__ void a_ready(const Unit&) const {}
    __device__ __forceinline__ void done(const Unit&) const {}
};
struct EpiSwiGLU {
    static constexpr bool PERM = true, AFTER_DRAIN = false;
    bf16_t* O; int ldc;
    __device__ __forceinline__ void operator()(const f32x4 (&acc)[2][2][4][2], const Unit& u, int wr, int wc, int fr, int fq) const {
        const int row0 = u.pm * BM + wr * 64 + fr; const int col0 = u.pn * 128 + wc * 16 + 4 * fq;
#pragma unroll
        for (int ai = 0; ai < 2; ++ai)
#pragma unroll
            for (int m = 0; m < 4; ++m) { bf16_t* rowp = O + (size_t)(row0 + ai * HALF + m * 16) * ldc + col0;
#pragma unroll
                for (int bj = 0; bj < 2; ++bj) { const f32x4 g = acc[ai][bj][m][0], up = acc[ai][bj][m][1]; float h[4];
#pragma unroll
                    for (int j = 0; j < 4; ++j) h[j] = g[j] / (1.0f + __expf(-g[j])) * up[j];
                    u32x2 w; w.x = cvt_pk_bf16(h[0], h[1]); w.y = cvt_pk_bf16(h[2], h[3]);
                    *(u32x2*)(rowp + bj * 64) = w; } }
    }
};
struct EpiRowScaleBf16 {
    static constexpr bool PERM = true, AFTER_DRAIN = false;
    bf16_t* O; int ldc; const float* rowscale;
    __device__ __forceinline__ void operator()(const f32x4 (&acc)[2][2][4][2], const Unit& u, int wr, int wc, int fr, int fq) const {
        const int row0 = u.pm * BM + wr * 64 + fr; const int col0 = u.pn * BM + wc * 32 + 8 * fq;
#pragma unroll
        for (int ai = 0; ai < 2; ++ai)
#pragma unroll
            for (int m = 0; m < 4; ++m) { const int row = row0 + ai * HALF + m * 16; const float sc = rowscale[row]; bf16_t* rowp = O + (size_t)row * ldc + col0;
#pragma unroll
                for (int bj = 0; bj < 2; ++bj) { const f32x4 v0 = acc[ai][bj][m][0] * sc, v1 = acc[ai][bj][m][1] * sc;
                    u32x4 w; w.x = cvt_pk_bf16(v0[0], v0[1]); w.y = cvt_pk_bf16(v0[2], v0[3]); w.z = cvt_pk_bf16(v1[0], v1[1]); w.w = cvt_pk_bf16(v1[2], v1[3]);
                    *(u32x4*)(rowp + bj * HALF) = w; } }
    }
};

template <class Epi, class Sched, bool ALIGN_EPI = false, bool SP2 = false>
__device__ __forceinline__ void gemm_phase(PG8_LAS unsigned char* lds, const Gemm g, const Sched& S, const Epi& E) {
    const int tid = threadIdx.x, wid = __builtin_amdgcn_readfirstlane(tid >> 6), lane = tid & 63, wr = wid >> 2, wc = wid & 3, fr = lane & 15, fq = lane >> 4;
    const int K = g.K, nt = K / BK;
    unsigned voffA[2], voffB[2];
#pragma unroll
    for (int i = 0; i < 2; ++i) { int R, C; stage_rc(tid * 16 + i * 8192, R, C); const int Rb = Epi::PERM ? ((R & ~31) + perm32(R & 31)) : R;
        voffA[i] = (unsigned)(R * g.lda + C * 2); voffB[i] = (unsigned)(Rb * g.ldb + C * 2); }
    const size_t kstepA = (size_t)g.kstepA, kstepB = (size_t)(BK * 2);
    const size_t hstepA = (size_t)HALF * g.lda, hstepB = (size_t)HALF * g.ldb;
    const unsigned ldsw = (unsigned)wid * 1024u;
    const int aoff = lds_byte(wr * 64 + fr, fq * 8), boff = lds_byte(wc * 32 + fr, fq * 8);
#define PG8_SA(b, h) (((b) * 2 + (h)) * HTB)
#define PG8_SB(b, h) ((4 + (b) * 2 + (h)) * HTB)
#define PG8_STAGE(bufoff, gbase, voff) do { _Pragma("unroll") for (int _i = 0; _i < 2; ++_i) \
        __builtin_amdgcn_global_load_lds((const unsigned*)((const char*)(gbase) + (voff)[_i]), (PG8_LAS unsigned*)(lds + (bufoff) + ldsw + _i * 8192), 16, 0, 0); } while (0)
#define PG8_LDA(dst, b, h) do { _Pragma("unroll") for (int m = 0; m < 4; ++m) _Pragma("unroll") for (int k = 0; k < 2; ++k) dst[m][k] = *(const PG8_LAS bf16x8*)(lds + PG8_SA(b, h) + aoff + m * 2048 + k * 1024); } while (0)
#define PG8_LDB(dst, b, h) do { _Pragma("unroll") for (int n = 0; n < 2; ++n) _Pragma("unroll") for (int k = 0; k < 2; ++k) dst[n][k] = *(const PG8_LAS bf16x8*)(lds + PG8_SB(b, h) + boff + n * 2048 + k * 1024); } while (0)
#define PG8_MMA(ai, bj, At, Bt) do { __builtin_amdgcn_s_setprio(1); _Pragma("unroll") for (int m = 0; m < 4; ++m) _Pragma("unroll") for (int n = 0; n < 2; ++n) _Pragma("unroll") for (int k = 0; k < 2; ++k) \
        acc[ai][bj][m][n] = __builtin_amdgcn_mfma_f32_16x16x32_bf16(Bt[n][k], At[m][k], acc[ai][bj][m][n], 0, 0, 0); __builtin_amdgcn_s_setprio(0); } while (0)
#define PG8_WAIT_V(n) asm volatile("s_waitcnt vmcnt(" #n ")" ::: "memory")
#define PG8_WAIT_L(n) asm volatile("s_waitcnt lgkmcnt(" #n ")" ::: "memory")
#define PG8_BAR __builtin_amdgcn_s_barrier()
#define PG8_SCHED __builtin_amdgcn_sched_barrier(0)
    Unit cur, nxt; int ui = 0;
    if (!S.next(0, cur)) return;
    f32x4 acc[2][2][4][2];
#pragma unroll
    for (int a = 0; a < 2; ++a)
#pragma unroll
        for (int b = 0; b < 2; ++b)
#pragma unroll
            for (int m = 0; m < 4; ++m)
#pragma unroll
                for (int n = 0; n < 2; ++n) acc[a][b][m][n] = (f32x4){0.f, 0.f, 0.f, 0.f};
    bf16x8 At[4][2], B0[2][2], B1[2][2];
    const char* cA = cur.a; const char* cB = cur.b;
    S.a_ready(cur);
    if constexpr (SP2) {
        PG8_STAGE(PG8_SB(0, 0), cB, voffB); PG8_STAGE(PG8_SB(0, 1), cB + hstepB, voffB); PG8_STAGE(PG8_SA(0, 0), cA, voffA); PG8_STAGE(PG8_SA(0, 1), cA + hstepA, voffA);
        if (wr == 1) PG8_BAR;
        PG8_WAIT_V(2); PG8_BAR;
        PG8_STAGE(PG8_SB(1, 0), cB + kstepB, voffB); PG8_STAGE(PG8_SA(1, 0), cA + kstepA, voffA); PG8_STAGE(PG8_SB(1, 1), cB + hstepB + kstepB, voffB);
        PG8_WAIT_V(6); PG8_BAR;
    } else {
        PG8_STAGE(PG8_SB(0, 0), cB, voffB); PG8_STAGE(PG8_SA(0, 0), cA, voffA); PG8_STAGE(PG8_SB(0, 1), cB + hstepB, voffB); PG8_STAGE(PG8_SA(0, 1), cA + hstepA, voffA);
        if (wr == 1) PG8_BAR;
        PG8_WAIT_V(4); PG8_BAR;
        PG8_STAGE(PG8_SB(1, 0), cB + kstepB, voffB); PG8_STAGE(PG8_SA(1, 0), cA + kstepA, voffA); PG8_STAGE(PG8_SB(1, 1), cB + hstepB + kstepB, voffB);
        PG8_WAIT_V(6); PG8_BAR;
    }
    for (;;) {
        const bool has_next = S.next(ui + 1, nxt);
        const char* nA = has_next ? nxt.a : cA; const char* nB = has_next ? nxt.b : cB;
        for (int t = 0; t < nt; t += 2) {
            const bool last = (t == nt - 2);
            const char* a1 = cA + (size_t)(t + 1) * kstepA;
            const char* a2 = last ? nA : cA + (size_t)(t + 2) * kstepA; const char* b2 = last ? nB : cB + (size_t)(t + 2) * kstepB;
            const char* a3 = a2 + kstepA; const char* b3 = b2 + kstepB;
            if (last && has_next) S.a_ready(nxt);
            if constexpr (SP2) {
            PG8_LDB(B0, 0, 0); PG8_LDB(B1, 0, 1); PG8_SCHED; PG8_LDA(At, 0, 0); PG8_STAGE(PG8_SA(1, 1), a1 + hstepA, voffA);
            PG8_WAIT_V(8); PG8_WAIT_L(0); PG8_BAR; PG8_MMA(0, 0, At, B0); PG8_MMA(0, 1, At, B1); PG8_BAR; PG8_SCHED;
            PG8_LDA(At, 0, 1); PG8_STAGE(PG8_SB(0, 0), b2, voffB); PG8_STAGE(PG8_SB(0, 1), b2 + hstepB, voffB); PG8_STAGE(PG8_SA(0, 0), a2, voffA);
            PG8_WAIT_V(8); PG8_WAIT_L(0); PG8_BAR; PG8_MMA(1, 0, At, B0); PG8_MMA(1, 1, At, B1); PG8_BAR; PG8_SCHED;
            PG8_LDB(B0, 1, 0); PG8_LDB(B1, 1, 1); PG8_SCHED; PG8_LDA(At, 1, 0); PG8_STAGE(PG8_SA(0, 1), a2 + hstepA, voffA);
            PG8_WAIT_V(8); PG8_WAIT_L(0); PG8_BAR; PG8_MMA(0, 0, At, B0); PG8_MMA(0, 1, At, B1); PG8_BAR; PG8_SCHED;
            PG8_LDA(At, 1, 1); PG8_STAGE(PG8_SB(1, 0), b3, voffB); PG8_STAGE(PG8_SB(1, 1), b3 + hstepB, voffB); PG8_STAGE(PG8_SA(1, 0), a3, voffA);
            PG8_WAIT_V(8); PG8_WAIT_L(0); PG8_BAR; PG8_MMA(1, 0, At, B0); PG8_MMA(1, 1, At, B1); PG8_BAR; PG8_SCHED;
            } else {
            PG8_LDB(B0, 0, 0); PG8_SCHED; PG8_LDA(At, 0, 0); PG8_STAGE(PG8_SA(1, 1), a1 + hstepA, voffA);
            PG8_WAIT_L(8); PG8_BAR; PG8_WAIT_L(0); PG8_MMA(0, 0, At, B0); PG8_BAR; PG8_SCHED;
            PG8_LDB(B1, 0, 1); PG8_STAGE(PG8_SB(0, 0), b2, voffB);
            PG8_BAR; PG8_WAIT_L(0); PG8_MMA(0, 1, At, B1); PG8_BAR;
            PG8_LDA(At, 0, 1); PG8_STAGE(PG8_SA(0, 0), a2, voffA);
            PG8_BAR; PG8_WAIT_L(0); PG8_MMA(1, 0, At, B0); PG8_BAR; PG8_SCHED;
            PG8_STAGE(PG8_SB(0, 1), b2 + hstepB, voffB);
            PG8_WAIT_V(6); PG8_BAR; PG8_MMA(1, 1, At, B1); PG8_BAR;
            PG8_LDB(B0, 1, 0); PG8_SCHED; PG8_LDA(At, 1, 0); PG8_STAGE(PG8_SA(0, 1), a2 + hstepA, voffA);
            PG8_WAIT_L(8); PG8_BAR; PG8_WAIT_L(0); PG8_MMA(0, 0, At, B0); PG8_BAR; PG8_SCHED;
            PG8_LDB(B1, 1, 1); PG8_STAGE(PG8_SB(1, 0), b3, voffB);
            PG8_BAR; PG8_WAIT_L(0); PG8_MMA(0, 1, At, B1); PG8_BAR;
            PG8_LDA(At, 1, 1); PG8_STAGE(PG8_SA(1, 0), a3, voffA);
            PG8_BAR; PG8_WAIT_L(0); PG8_MMA(1, 0, At, B0); PG8_BAR; PG8_SCHED;
            PG8_STAGE(PG8_SB(1, 1), b3 + hstepB, voffB);
            PG8_WAIT_V(6); PG8_BAR; PG8_MMA(1, 1, At, B1); PG8_BAR;
            }
        }
        if constexpr (ALIGN_EPI) { if (wr == 0) PG8_BAR; }
        if constexpr (!Epi::AFTER_DRAIN) { E(acc, cur, wr, wc, fr, fq); S.done(cur); }
        if (!has_next) break;
#pragma unroll
        for (int a = 0; a < 2; ++a)
#pragma unroll
            for (int b = 0; b < 2; ++b)
#pragma unroll
                for (int m = 0; m < 4; ++m)
#pragma unroll
                    for (int n = 0; n < 2; ++n) acc[a][b][m][n] = (f32x4){0.f, 0.f, 0.f, 0.f};
        cur = nxt; cA = nA; cB = nB; ++ui;
        if constexpr (ALIGN_EPI) { if (wr == 1) PG8_BAR; }
    }
    PG8_WAIT_V(0);
    if constexpr (!ALIGN_EPI) { if (wr == 0) PG8_BAR; }
    PG8_BAR;
    if constexpr (Epi::AFTER_DRAIN) { E.fused(acc, cur, wr, wc, fr, fq, lds, wid, lane); S.done(cur); }
#undef PG8_SA
#undef PG8_SB
#undef PG8_STAGE
#undef PG8_LDA
#undef PG8_LDB
#undef PG8_MMA
#undef PG8_WAIT_V
#undef PG8_WAIT_L
#undef PG8_BAR
#undef PG8_SCHED
}
}

#define GAS __attribute__((address_space(1)))
#define LAS __attribute__((address_space(3)))
typedef unsigned short bf16;
typedef unsigned v4u __attribute__((ext_vector_type(4)));
typedef unsigned v2u __attribute__((ext_vector_type(2)));
typedef float f32x4 __attribute__((ext_vector_type(4)));
typedef float f32x16 __attribute__((ext_vector_type(16)));
typedef short bf16x8 __attribute__((ext_vector_type(8)));
typedef short s16x4 __attribute__((ext_vector_type(4)));
typedef GAS unsigned gu32;
#define RLX_AGENT __ATOMIC_RELAXED, __HIP_MEMORY_SCOPE_AGENT
#define LDS_WAIT() asm volatile("s_waitcnt lgkmcnt(0)" ::: "memory")
#define VM_WAIT() asm volatile("s_waitcnt vmcnt(0)" ::: "memory")
__device__ __forceinline__ unsigned f2bf(float f) { unsigned u = __builtin_bit_cast(unsigned, f); return (u + 0x7fffu + ((u >> 16) & 1u)) >> 16; }
__device__ __forceinline__ unsigned pk2(float lo, float hi) { return f2bf(lo) | (f2bf(hi) << 16); }
__device__ __forceinline__ float bf2f(unsigned b) { return __builtin_bit_cast(float, b << 16); }
__device__ __forceinline__ float bflo(unsigned w) { return __builtin_bit_cast(float, w << 16); }
__device__ __forceinline__ float bfhi(unsigned w) { return __builtin_bit_cast(float, w & 0xffff0000u); }
__device__ __forceinline__ float wave_sum(float v) {
#pragma unroll
    for (int o = 1; o < 64; o <<= 1) v += __shfl_xor(v, o);
    return v;
}
__device__ __forceinline__ float wave_max(float v) {
#pragma unroll
    for (int o = 1; o < 64; o <<= 1) v = fmaxf(v, __shfl_xor(v, o));
    return v;
}

#define XB_TMO      128
#define XB_XCNT(j)  (256  + 64 * (j))
#define XB_XSUB(j)  (1280 + 64 * (j))
#define XB_XGEN(j)  (2304 + 64 * (j))
#define XB_TOP      3328
#define XB_TOPGEN   3392
#define XCD_BAR_WORDS 3456
#define XB_SPIN_CAP (1u << 18)

__device__ __forceinline__ unsigned xb_ld(unsigned* p)              { return __hip_atomic_load(p, __ATOMIC_RELAXED, __HIP_MEMORY_SCOPE_AGENT); }
__device__ __forceinline__ unsigned xb_add(unsigned* p, unsigned v) { return __hip_atomic_fetch_add(p, v, __ATOMIC_RELAXED, __HIP_MEMORY_SCOPE_AGENT); }
__device__ __forceinline__ unsigned xb_xcc_id() { return (unsigned)__builtin_amdgcn_s_getreg((3 << 11) | 20) & 0xFu; }
#define XB_SPIN(cond, bar) do { unsigned _sp = 0; while (cond) { __builtin_amdgcn_s_sleep(1); \
    if ((++_sp & 255u) == 0u) { if (xb_ld(&(bar)[XB_TMO])) break; if (_sp > XB_SPIN_CAP) { atomicAdd(&(bar)[XB_TMO], 1u); break; } } } } while (0)

struct XcdBarrier {
    unsigned* bar; unsigned x;
    volatile LAS unsigned* st;
};

__device__ __forceinline__ XcdBarrier xcd_barrier_post(unsigned* bar, volatile LAS unsigned* st) {
    XcdBarrier b; b.bar = bar; b.x = xb_xcc_id(); b.st = st;
    if (threadIdx.x == 0) (void)xb_add(&bar[XB_XCNT(b.x)], 1u);
    return b;
}
__device__ __forceinline__ void xcd_barrier_complete(unsigned* bar, unsigned x, unsigned& nloc, unsigned& nx) {
    const unsigned G = gridDim.x * gridDim.y * gridDim.z;
    unsigned sum, cnt, mine, sp = 0u;
    for (;;) {
        sum = 0u; cnt = 0u; mine = 0u;
#pragma unroll
        for (unsigned j = 0; j < 16; ++j) { const unsigned c = xb_ld(&bar[XB_XCNT(j)]); sum += c; cnt += (c > 0u) ? 1u : 0u; mine = (j == x) ? c : mine; }
        if (sum == G) break;
        __builtin_amdgcn_s_sleep(1);
        if ((++sp & 255u) == 0u) { if (xb_ld(&bar[XB_TMO])) break; if (sp > XB_SPIN_CAP) { atomicAdd(&bar[XB_TMO], 1u); break; } }
    }
    nloc = mine > 0u ? mine : 1u; nx = cnt > 0u ? cnt : 1u;
}

__device__ __forceinline__ void xcd_barrier(const XcdBarrier& b) {
    asm volatile("s_waitcnt vmcnt(0)" ::: "memory");
    __syncthreads();
    if (threadIdx.x == 0) {
        unsigned* bar = b.bar;
        __builtin_amdgcn_s_waitcnt(0);
        unsigned nloc = b.st[0], nx = b.st[1];
        if (nloc == 0u) { xcd_barrier_complete(bar, b.x, nloc, nx); b.st[0] = nloc; b.st[1] = nx; }
        const unsigned old = xb_add(&bar[XB_XSUB(b.x)], 1u);
        const unsigned gen = old / nloc;
        if (old + 1u == (gen + 1u) * nloc) {
            __builtin_amdgcn_fence(__ATOMIC_RELEASE, "agent");
            asm volatile("s_waitcnt vmcnt(0)" ::: "memory");
            const unsigned og = xb_add(&bar[XB_TOP], 1u);
            const unsigned tg = og / nx;
            if (og + 1u == (tg + 1u) * nx) xb_add(&bar[XB_TOPGEN], 1u);
            else XB_SPIN(xb_ld(&bar[XB_TOPGEN]) == tg, bar);
            __builtin_amdgcn_fence(__ATOMIC_ACQUIRE, "agent");
            xb_add(&bar[XB_XGEN(b.x)], 1u);
            asm volatile("s_waitcnt vmcnt(0)" ::: "memory");
        } else {
            XB_SPIN(xb_ld(&bar[XB_XGEN(b.x)]) == gen, bar);
            __builtin_amdgcn_fence(__ATOMIC_ACQUIRE, "agent");
            asm volatile("s_waitcnt vmcnt(0)" ::: "memory");
        }
    }
    __syncthreads();
}

constexpr int NWAVES = 8;
constexpr int NTOK = 16384, SEQ = 4096, DM = 2048;
constexpr int LDP = 6912;
constexpr int C_HQ = 0, C_HF = 1024, C_HI = 2048, C_HG = 3072, C_NQ = 4096, C_KC = 5120, C_VC = 5376, C_KS = 5632, C_VS = 5888, C_KW = 6144, C_VW = 6400, C_GR = 6656, IN_COLS = 6704;
constexpr float EPS = 1e-6f;
constexpr int MAXSLOT = 40960;
constexpr int MAXTILE = MAXSLOT / 256;

constexpr size_t MiB = 1u << 20;
constexpr size_t WS_CTL = 0, CTL_ZERO_BYTES = 1 * MiB;
constexpr size_t WS_SM = 1 * MiB;
constexpr size_t SM_LB = WS_SM + 0, SM_B1K = WS_SM + 4096, SM_B1V = WS_SM + 8192, SM_W2KT = WS_SM + 16384, SM_W2VT = WS_SM + 49152;
constexpr size_t SM_COS = WS_SM + 128 * 1024, SM_SIN = SM_COS + 512 * 1024;
constexpr size_t SM_W1KT = WS_SM + 2 * MiB, SM_W1VT = WS_SM + 3 * MiB;
constexpr size_t SM_EID = WS_SM + 5 * MiB, SM_EW = SM_EID + 128 * 1024, SM_TSLOT = SM_EW + 128 * 1024, SM_STOK = SM_TSLOT + 128 * 1024, SM_SW = SM_STOK + 160 * 1024, SM_TILEE = SM_SW + 160 * 1024;
constexpr size_t WS_KC = 11 * MiB, WS_VC = 11 * MiB + 512 * 1024;
constexpr size_t WS_WINT = 12 * MiB;
constexpr size_t WS_WOT = 39 * MiB;
constexpr size_t WS_B = 47 * MiB;
constexpr size_t WS_PROJ = 111 * MiB;
constexpr size_t WS_WGUT = WS_PROJ, WS_HIDM = WS_PROJ + 128 * MiB;
constexpr size_t WS_D = 328 * MiB;
constexpr size_t WS_OI = WS_D, WS_U = WS_D + 32 * MiB, WS_DD = WS_D + 96 * MiB, WS_ONSA = WS_D + 97 * MiB;
constexpr size_t WS_WDT = WS_D, WS_XG = WS_D + 64 * MiB;
constexpr size_t WS_END = WS_XG + 160 * MiB;
static_assert(WS_END <= 584 * MiB, "workspace map");
constexpr int CW_TMO = 0, CW_CODE = 1, CW_BAR = 4096, CW_CNT = 8192, CW_CUR = 8192 + 64;

constexpr int RING_OFF = 0, RING_BYTES = 131072;
constexpr int LDSCTL_OFF = RING_BYTES, MISC_OFF = LDSCTL_OFF + 320;
constexpr int LDS_BYTES = 147456;

struct Frame {
    LAS unsigned char* lds;
    volatile LAS unsigned* MISC;
    gu32* ctl;
    int tid, lane, wave, vcu, G;
    const float* in[22]; float* out; unsigned char* ws;
};
#define IN_X 0
#define IN_ATTN_NORM 1
#define IN_W_IN 2
#define IN_LB 3
#define IN_HG_NORM 4
#define IN_POS_K 5
#define IN_W1_K 6
#define IN_W2_K 7
#define IN_POS_V 8
#define IN_W1_V 9
#define IN_W2_V 10
#define IN_NSA_NORM 11
#define IN_W_OUT 12
#define IN_FFN_NORM 13
#define IN_W_GROUP 14
#define IN_B_GROUP 15
#define IN_W_ROUTER 16
#define IN_B_ROUTER 17
#define IN_W_GATE 18
#define IN_W_UP 19
#define IN_W_DOWN 20
#define IN_FINAL_NORM 21

__device__ __forceinline__ void transpose_item(const float* W, int ldn, int Nvalid, bf16* WT, int Kd, LAS float* scr, int k0, int n0, int lane, int ilv = -1) {
#pragma unroll 8
    for (int i = 0; i < 32; ++i) { const int kk = 2 * i + (lane >> 5); const int n = n0 + (lane & 31); scr[kk * 33 + (lane & 31)] = (n < Nvalid) ? W[(size_t)(k0 + kk) * ldn + n] : 0.f; }
    LDS_WAIT();
    const int c = lane & 7;
#pragma unroll
    for (int j = 0; j < 4; ++j) { const int n = (lane >> 3) + 8 * j; const LAS float* s = scr + (8 * c) * 33 + n;
        v4u o; o.x = pk2(s[0 * 33], s[1 * 33]); o.y = pk2(s[2 * 33], s[3 * 33]); o.z = pk2(s[4 * 33], s[5 * 33]); o.w = pk2(s[6 * 33], s[7 * 33]);
        const int nn = n0 + n; const int drow = (ilv < 0) ? nn : (8 * (nn >> 2) + (nn & 3) + ilv);
        *(v4u*)(WT + (size_t)drow * Kd + k0 + 8 * c) = o; }
    LDS_WAIT();
}
__device__ __forceinline__ void rms_row_to_bf16(const float* xrow, const float* gain, bf16* orow, int lane) {
    const f32x4* xr = (const f32x4*)xrow + lane; const f32x4* gr = (const f32x4*)gain + lane;
    f32x4 v[8]; float s = 0.f;
#pragma unroll
    for (int j = 0; j < 8; ++j) { v[j] = xr[64 * j]; s += (v[j].x * v[j].x + v[j].y * v[j].y) + (v[j].z * v[j].z + v[j].w * v[j].w); }
    const float rstd = 1.0f / sqrtf(wave_sum(s) * (1.f / DM) + EPS);
    unsigned long long* o8 = (unsigned long long*)orow + lane;
#pragma unroll
    for (int j = 0; j < 8; ++j) { const f32x4 g = gr[64 * j]; o8[64 * j] = (unsigned long long)pk2(v[j].x * rstd * g.x, v[j].y * rstd * g.y) | ((unsigned long long)pk2(v[j].z * rstd * g.z, v[j].w * rstd * g.w) << 32); }
}
__device__ __forceinline__ void p0_prologue(Frame& F) {
    LAS float* scr = (LAS float*)(F.lds + RING_OFF + F.wave * 16384);
    const int gw = F.vcu * NWAVES + F.wave, NGW = F.G * NWAVES;
    constexpr int I_IN = 32 * (LDP / 32), I_O = 32 * 64, I_W1 = 32 * 8, I_W2 = 4 * 2;
    constexpr int NITEMS = I_IN + I_O + 2 * I_W1 + 2 * I_W2;
    for (int it = gw; it < NITEMS; it += NGW) {
        int r = it;
        if (r < I_IN) { const int nblk = LDP / 32; transpose_item(F.in[IN_W_IN], IN_COLS, IN_COLS, (bf16*)(F.ws + WS_WINT), DM, scr, 64 * (r / nblk), 32 * (r % nblk), F.lane); continue; } r -= I_IN;
        if (r < I_O) { transpose_item(F.in[IN_W_OUT], DM, DM, (bf16*)(F.ws + WS_WOT), DM, scr, 64 * (r / 64), 32 * (r % 64), F.lane); continue; } r -= I_O;
        if (r < I_W1) { transpose_item(F.in[IN_W1_K], 256, 256, (bf16*)(F.ws + SM_W1KT), 2048, scr, 64 * (r / 8), 32 * (r % 8), F.lane); continue; } r -= I_W1;
        if (r < I_W1) { transpose_item(F.in[IN_W1_V], 256, 256, (bf16*)(F.ws + SM_W1VT), 2048, scr, 64 * (r / 8), 32 * (r % 8), F.lane); continue; } r -= I_W1;
        if (r < I_W2) { transpose_item(F.in[IN_W2_K], 64, 64, (bf16*)(F.ws + SM_W2KT), 256, scr, 64 * (r / 2), 32 * (r % 2), F.lane); continue; } r -= I_W2;
        transpose_item(F.in[IN_W2_V], 64, 64, (bf16*)(F.ws + SM_W2VT), 256, scr, 64 * (r / 2), 32 * (r % 2), F.lane);
    }
    bf16* H = (bf16*)(F.ws + WS_B);
    for (int m = gw; m < NTOK; m += NGW) rms_row_to_bf16(F.in[IN_X] + (size_t)m * DM, F.in[IN_ATTN_NORM], H + (size_t)m * DM, F.lane);
    const int gt = F.vcu * (NWAVES * 64) + F.tid, NT = F.G * NWAVES * 64;
    float* LB = (float*)(F.ws + SM_LB);
    for (int i = gt; i < 1024; i += NT) { const float a0 = F.in[IN_LB][i], a1 = F.in[IN_LB][1024 + i]; LB[i] = 1.0f / (1.0f + expf(a1 - a0)); }
    float* COS = (float*)(F.ws + SM_COS); float* SIN = (float*)(F.ws + SM_SIN);
    for (int i = gt; i < SEQ * 32; i += NT) { const int t = i >> 5, k = i & 31;
        const double inv = exp2(-(double)k * (13.287712379549449 / 32.0));
        double rev = (double)t * inv * 0.15915494309189535; rev -= rint(rev);
        COS[i] = __builtin_amdgcn_cosf((float)rev); SIN[i] = __builtin_amdgcn_sinf((float)rev); }
    for (int it = gw; it < 8; it += NGW) { const int br = it >> 2, j = (it & 3) * 64 + F.lane; const float* pos = F.in[br ? IN_POS_V : IN_POS_K]; const float* w1 = F.in[br ? IN_W1_V : IN_W1_K];
        float a = 0.f; for (int k = 0; k < 2048; ++k) a += pos[k] * w1[(size_t)k * 256 + j];
        ((float*)(F.ws + (br ? SM_B1V : SM_B1K)))[j] = a; }
    unsigned* pad = (unsigned*)((bf16*)(F.ws + WS_PROJ) + (size_t)NTOK * LDP);
    for (int i = gt; i < 16 * LDP / 2; i += NT) pad[i] = 0u;
}

__device__ __forceinline__ void n2_rope_compress(Frame& F) {
    bf16* PROJ = (bf16*)(F.ws + WS_PROJ);
    const float* COS = (const float*)(F.ws + SM_COS); const float* SIN = (const float*)(F.ws + SM_SIN);
    const int gt = F.vcu * (NWAVES * 64) + F.tid, NT = F.G * NWAVES * 64;
    for (int idx = gt; idx < NTOK * 256; idx += NT) { const int i = idx & 31, g = (idx >> 5) & 3, ten = (idx >> 7) & 1, tok = idx >> 8, pos = tok & (SEQ - 1);
        bf16* p = PROJ + (size_t)tok * LDP + (ten ? C_KW : C_KS) + g * 64 + i;
        const float a = bf2f(p[0]), b = bf2f(p[32]), c = COS[pos * 32 + i], s = SIN[pos * 32 + i];
        p[0] = (bf16)f2bf(a * c - b * s); p[32] = (bf16)f2bf(b * c + a * s); }
    LAS float* scr = (LAS float*)(F.lds + RING_OFF + F.wave * 16384);
    const int gw = F.vcu * NWAVES + F.wave, NGW = F.G * NWAVES;
    for (int it = gw; it < 2 * 4080; it += NGW) {
        const int br = it / 4080; int r = it % 4080; const int b = r / 1020; r %= 1020; const int c = r >> 2, g = r & 3;
        const float* pos = F.in[br ? IN_POS_V : IN_POS_K]; const float* w1 = F.in[br ? IN_W1_V : IN_W1_K]; const float* w2 = F.in[br ? IN_W2_V : IN_W2_K];
        const bf16* src = PROJ + (size_t)(b * SEQ + c * 16) * LDP + (br ? C_VC : C_KC) + g * 64;
        for (int k = F.lane; k < 2048; k += 64) scr[k] = bf2f(src[(size_t)(k >> 6) * LDP + (k & 63)]) + pos[k];
        LDS_WAIT();
        float a0 = 0.f, a1 = 0.f, a2 = 0.f, a3 = 0.f;
        for (int k = 0; k < 2048; ++k) { const float f = scr[k]; const float* w = w1 + (size_t)k * 256 + F.lane; a0 += f * w[0]; a1 += f * w[64]; a2 += f * w[128]; a3 += f * w[192]; }
        scr[2048 + F.lane] = pg8::gelu_tanh(a0); scr[2048 + 64 + F.lane] = pg8::gelu_tanh(a1); scr[2048 + 128 + F.lane] = pg8::gelu_tanh(a2); scr[2048 + 192 + F.lane] = pg8::gelu_tanh(a3);
        LDS_WAIT();
        float o = 0.f;
        for (int j = 0; j < 256; ++j) o += scr[2048 + j] * w2[j * 64 + F.lane];
        ((bf16*)(F.ws + (br ? WS_VC : WS_KC)))[((size_t)(b * 256 + c) * 4 + g) * 64 + F.lane] = (bf16)f2bf(o);
        LDS_WAIT();
    }
}

__device__ __forceinline__ void n3_hgrn(Frame& F, int bh) {
    const int b = bh >> 3, h = bh & 7;
    const bf16* PROJ = (const bf16*)(F.ws + WS_PROJ); bf16* Y = (bf16*)(F.ws + WS_B);
    const float* LB = (const float*)(F.ws + SM_LB); const float* gain = F.in[IN_HG_NORM];
    LAS float* qs = (LAS float*)(F.lds); LAS float* fs = qs + 2048; LAS float* is = fs + 2048; LAS float* po = is + 2048;
    const int v = F.tid & 127, kq = F.tid >> 7;
    float S[32];
#pragma unroll
    for (int i = 0; i < 32; ++i) S[i] = 0.f;
    for (int blk = 0; blk < SEQ / 16; ++blk) {
        const int t0 = blk * 16;
        for (int e = F.tid; e < 2048; e += 512) { const int s = e >> 7, k = e & 127; const bf16* row = PROJ + (size_t)(b * SEQ + t0 + s) * LDP + h * 128 + k;
            const float lb = LB[h * 128 + k];
            qs[e] = bf2f(row[C_HQ]) * 0.08838834764831845f;
            fs[e] = lb + (1.0f - lb) / (1.0f + __expf(-bf2f(row[C_HF])));
            is[e] = bf2f(row[C_HI]); }
        __syncthreads();
        for (int s = 0; s < 16; ++s) { const float vv = is[s * 128 + v]; float acc = 0.f;
#pragma unroll
            for (int i = 0; i < 32; ++i) { const float f = fs[s * 128 + kq * 32 + i], q = qs[s * 128 + kq * 32 + i]; S[i] = f * S[i] + (1.0f - f) * vv; acc += q * S[i]; }
            po[(s * 4 + kq) * 128 + v] = acc; }
        __syncthreads();
#pragma unroll
        for (int ss = 0; ss < 2; ++ss) { const int s = F.wave * 2 + ss; const int tok = b * SEQ + t0 + s;
            const float o0 = (po[(s * 4 + 0) * 128 + F.lane] + po[(s * 4 + 1) * 128 + F.lane]) + (po[(s * 4 + 2) * 128 + F.lane] + po[(s * 4 + 3) * 128 + F.lane]);
            const float o1 = (po[(s * 4 + 0) * 128 + 64 + F.lane] + po[(s * 4 + 1) * 128 + 64 + F.lane]) + (po[(s * 4 + 2) * 128 + 64 + F.lane] + po[(s * 4 + 3) * 128 + 64 + F.lane]);
            const float rstd = 1.0f / sqrtf(wave_sum(o0 * o0 + o1 * o1) * (1.f / 128.f) + EPS);
            const bf16* grow = PROJ + (size_t)tok * LDP + C_HG + h * 128;
            const float g0 = bf2f(grow[F.lane]), g1 = bf2f(grow[64 + F.lane]);
            Y[(size_t)tok * DM + h * 128 + F.lane] = (bf16)f2bf(o0 * rstd * gain[F.lane] * (g0 / (1.0f + __expf(-g0))));
            Y[(size_t)tok * DM + h * 128 + 64 + F.lane] = (bf16)f2bf(o1 * rstd * gain[64 + F.lane] * (g1 / (1.0f + __expf(-g1)))); }
        __syncthreads();
    }
}
__device__ __forceinline__ float dot64(const LAS float* q, const bf16* krow) {
    const v4u* kr = (const v4u*)krow; float s = 0.f;
#pragma unroll
    for (int j = 0; j < 8; ++j) { const v4u w = kr[j]; const LAS float* qq = q + 8 * j;
        s += qq[0] * bflo(w.x) + qq[1] * bfhi(w.x) + qq[2] * bflo(w.y) + qq[3] * bfhi(w.y) + qq[4] * bflo(w.z) + qq[5] * bfhi(w.z) + qq[6] * bflo(w.w) + qq[7] * bfhi(w.w); }
    return s;
}
__device__ __forceinline__ void n3_attn_item(Frame& F, int item, LAS float* scr) {
    const bf16* PROJ = (const bf16*)(F.ws + WS_PROJ);
    const bf16* KC = (const bf16*)(F.ws + WS_KC); const bf16* VC = (const bf16*)(F.ws + WS_VC);
    const float* COS = (const float*)(F.ws + SM_COS); const float* SIN = (const float*)(F.ws + SM_SIN);
    float* ONSA = (float*)(F.ws + WS_ONSA);
    const int lane = F.lane;
    const int g = item & 3, tok = item >> 2, b = tok >> 12, t = tok & (SEQ - 1), cur = t >> 6;
    LAS float* qf = scr; LAS float* qr = scr + 256; LAS float* ps = scr + 512; LAS float* pc = scr + 768; LAS float* pb = scr + 1024;
    const bf16* qrow = PROJ + (size_t)tok * LDP + C_NQ + g * 256;
#pragma unroll
    for (int r = 0; r < 4; ++r) { const float q = bf2f(qrow[r * 64 + lane]); qf[r * 64 + lane] = q;
        const float qp = bf2f(qrow[r * 64 + (lane ^ 32)]); const float c = COS[t * 32 + (lane & 31)], s = SIN[t * 32 + (lane & 31)];
        qr[r * 64 + lane] = (lane < 32) ? (q * c - qp * s) : (q * c + qp * s); }
#pragma unroll
    for (int i = 0; i < 4; ++i) ps[i * 64 + lane] = 0.f;
    LDS_WAIT();
    const int nvalid = (t >= 31) ? ((t - 31) >> 4) + 1 : 0;
    float oc[4];
#pragma unroll
    for (int r = 0; r < 4; ++r) {
        float s[4]; float m = -3.0e38f;
#pragma unroll
        for (int i = 0; i < 4; ++i) { const int c = lane + 64 * i; s[i] = (c < nvalid) ? dot64(qf + r * 64, KC + ((size_t)(b * 256 + c) * 4 + g) * 64) * 0.125f : -3.0e38f; m = fmaxf(m, s[i]); }
        m = wave_max(m); float e[4]; float sum = 0.f;
#pragma unroll
        for (int i = 0; i < 4; ++i) { const int c = lane + 64 * i; e[i] = (c < nvalid) ? __expf(s[i] - m) : 0.f; sum += e[i]; }
        sum = wave_sum(sum); const float inv = (nvalid > 0) ? 1.0f / sum : 0.f;
#pragma unroll
        for (int i = 0; i < 4; ++i) { const float p = e[i] * inv; pc[i * 64 + lane] = p; ps[i * 64 + lane] += p; }
        LDS_WAIT();
        float a = 0.f;
        for (int c = 0; c < nvalid; ++c) a += pc[c] * bf2f(VC[((size_t)(b * 256 + c) * 4 + g) * 64 + lane]);
        oc[r] = a;
        LDS_WAIT();
    }
    float imp = 0.f;
#pragma unroll
    for (int dc = -1; dc <= 3; ++dc) { const int c = 4 * lane + dc; if (c >= 0 && c <= 254) imp += ps[c]; }
    const bool forced = (lane == 0) || (lane == cur) || (lane == cur - 1);
    const bool causal = lane <= cur;
    const float val = forced ? 1.0e9f : (causal ? imp : -1.0e9f);
    int rank = 0;
    for (int i = 0; i < 64; ++i) { const float vi = __shfl(val, i); rank += (vi > val || (vi == val && i < lane)) ? 1 : 0; }
    const unsigned long long selmask = __ballot((rank < 16) && causal);
    const bf16* gr = PROJ + (size_t)tok * LDP + C_GR + g * 12;
#pragma unroll
    for (int r = 0; r < 4; ++r) {
        float m = -3.0e38f, l = 0.f, acc = 0.f;
        unsigned long long mk = selmask;
        while (mk) { const int jb = __builtin_ctzll(mk); mk &= mk - 1;
            const int pos = jb * 64 + lane; const bool valid = pos <= t;
            const float s = valid ? dot64(qr + r * 64, PROJ + (size_t)(b * SEQ + pos) * LDP + C_KS + g * 64) * 0.125f : -3.0e38f;
            const float mn = fmaxf(m, wave_max(s)); const float alpha = __expf(m - mn); const float p = valid ? __expf(s - mn) : 0.f;
            l = l * alpha + wave_sum(p); acc *= alpha; pb[lane] = p; LDS_WAIT();
            const bf16* vb = PROJ + (size_t)(b * SEQ + jb * 64) * LDP + C_VS + g * 64 + lane;
            for (int k = 0; k < 64; ++k) acc += pb[k] * bf2f(vb[(size_t)k * LDP]);
            m = mn; LDS_WAIT(); }
        const float os = acc / l;
        m = -3.0e38f; l = 0.f; acc = 0.f;
        for (int i = 0; i < 8; ++i) { const int base = t - 511 + 64 * i; if (base + 63 < 0) continue;
            const int pos = base + lane; const bool valid = pos >= 0;
            const float s = valid ? dot64(qr + r * 64, PROJ + (size_t)(b * SEQ + pos) * LDP + C_KW + g * 64) * 0.125f : -3.0e38f;
            const float mn = fmaxf(m, wave_max(s)); const float alpha = __expf(m - mn); const float p = valid ? __expf(s - mn) : 0.f;
            l = l * alpha + wave_sum(p); acc *= alpha; pb[lane] = p; LDS_WAIT();
            const int k0 = base < 0 ? -base : 0;
            const bf16* vb = PROJ + (size_t)(b * SEQ) * LDP + C_VW + g * 64 + lane;
            for (int k = k0; k < 64; ++k) acc += pb[k] * bf2f(vb[(size_t)(base + k) * LDP]);
            m = mn; LDS_WAIT(); }
        const float ow = acc / l;
        const float gc = 1.0f / (1.0f + __expf(-bf2f(gr[r * 3 + 0]))), gs = 1.0f / (1.0f + __expf(-bf2f(gr[r * 3 + 1]))), gw = 1.0f / (1.0f + __expf(-bf2f(gr[r * 3 + 2])));
        ONSA[(size_t)tok * 1024 + (g * 4 + r) * 64 + lane] = gc * oc[r] + gs * os + gw * ow;
    }
}
__device__ __forceinline__ void n3_mixers(Frame& F) {
    if (F.vcu < 32) n3_hgrn(F, F.vcu);
    LAS float* scr = (LAS float*)(F.lds + RING_OFF + F.wave * 16384);
    const int gw = F.vcu * NWAVES + F.wave, NGW = F.G * NWAVES;
    for (int it = gw; it < NTOK * 4; it += NGW) n3_attn_item(F, it, scr);
}
__device__ __forceinline__ void n4_nsanorm(Frame& F) {
    const float* ONSA = (const float*)(F.ws + WS_ONSA); bf16* Y = (bf16*)(F.ws + WS_B); const float* gain = F.in[IN_NSA_NORM];
    const int gw = F.vcu * NWAVES + F.wave, NGW = F.G * NWAVES;
    for (int tok = gw; tok < NTOK; tok += NGW) {
        const f32x4* xr = (const f32x4*)(ONSA + (size_t)tok * 1024) + F.lane; const f32x4* gr = (const f32x4*)gain + F.lane;
        f32x4 v[4]; float s = 0.f;
#pragma unroll
        for (int j = 0; j < 4; ++j) { v[j] = xr[64 * j]; s += (v[j].x * v[j].x + v[j].y * v[j].y) + (v[j].z * v[j].z + v[j].w * v[j].w); }
        const float rstd = 1.0f / sqrtf(wave_sum(s) * (1.f / 1024.f) + EPS);
        unsigned long long* o8 = (unsigned long long*)(Y + (size_t)tok * DM + 1024) + F.lane;
#pragma unroll
        for (int j = 0; j < 4; ++j) { const f32x4 g = gr[64 * j]; o8[64 * j] = (unsigned long long)pk2(v[j].x * rstd * g.x, v[j].y * rstd * g.y) | ((unsigned long long)pk2(v[j].z * rstd * g.z, v[j].w * rstd * g.w) << 32); }
    }
}
__device__ __forceinline__ void p6_router(Frame& F) {
    const float* X2 = F.out; bf16* XN2 = (bf16*)(F.ws + WS_B);
    const float* gain = F.in[IN_FFN_NORM]; const float* wg = F.in[IN_W_GROUP]; const float* wr = F.in[IN_W_ROUTER];
    int* EID = (int*)(F.ws + SM_EID); float* EW = (float*)(F.ws + SM_EW);
    const int gw = F.vcu * NWAVES + F.wave, NGW = F.G * NWAVES;
    {
        LAS float* scr = (LAS float*)(F.lds + RING_OFF + F.wave * 16384);
        bf16* WGUT = (bf16*)(F.ws + WS_WGUT); bf16* WDT = (bf16*)(F.ws + WS_WDT);
        for (int it = gw; it < 3 * 16384; it += NGW) { const int which = it >> 14, r = it & 16383, e = r >> 9, q = r & 511;
            if (which < 2) transpose_item(F.in[which ? IN_W_UP : IN_W_GATE] + (size_t)e * DM * 512, 512, 512, WGUT + (size_t)e * 1024 * DM, DM, scr, 64 * (q >> 4), 32 * (q & 15), F.lane, which ? 4 : 0);
            else transpose_item(F.in[IN_W_DOWN] + (size_t)e * 512 * DM, DM, DM, WDT + (size_t)e * DM * 512, 512, scr, 64 * (q >> 6), 32 * (q & 63), F.lane); }
    }
    for (int tok = gw; tok < NTOK; tok += NGW) {
        const f32x4* xr = (const f32x4*)(X2 + (size_t)tok * DM) + F.lane; const f32x4* gr = (const f32x4*)gain + F.lane;
        f32x4 v[8]; float s = 0.f;
#pragma unroll
        for (int j = 0; j < 8; ++j) { v[j] = xr[64 * j]; s += (v[j].x * v[j].x + v[j].y * v[j].y) + (v[j].z * v[j].z + v[j].w * v[j].w); }
        const float rstd = 1.0f / sqrtf(wave_sum(s) * (1.f / DM) + EPS);
        unsigned long long* o8 = (unsigned long long*)(XN2 + (size_t)tok * DM) + F.lane;
#pragma unroll
        for (int j = 0; j < 8; ++j) { const f32x4 g = gr[64 * j]; v[j].x *= rstd * g.x; v[j].y *= rstd * g.y; v[j].z *= rstd * g.z; v[j].w *= rstd * g.w;
            o8[64 * j] = (unsigned long long)pk2(v[j].x, v[j].y) | ((unsigned long long)pk2(v[j].z, v[j].w) << 32); }
        LAS float* xs = (LAS float*)(F.lds + RING_OFF + F.wave * 16384);
#pragma unroll
        for (int j = 0; j < 8; ++j) *(LAS f32x4*)(xs + 4 * (64 * j + F.lane)) = v[j];
        LDS_WAIT();
        {
            const bool act = F.lane < 36; const float* wp = (F.lane < 4) ? (wg + F.lane) : (wr + (F.lane - 4)); const int st = (F.lane < 4) ? 4 : 32;
            float a0 = 0.f, a1 = 0.f, a2 = 0.f, a3 = 0.f;
            if (act) for (int d4 = 0; d4 < DM / 4; ++d4) { const f32x4 x4 = *(const LAS f32x4*)(xs + 4 * d4); const float* w = wp + (size_t)(4 * d4) * st;
                a0 += x4.x * w[0]; a1 += x4.y * w[st]; a2 += x4.z * w[2 * st]; a3 += x4.w * w[3 * st]; }
            xs[2048 + F.lane] = (a0 + a1) + (a2 + a3);
        }
        LDS_WAIT();
        float L[36];
#pragma unroll
        for (int o = 0; o < 36; ++o) L[o] = xs[2048 + o];
        if (F.lane == 0) {
            float gl[4];
#pragma unroll
            for (int i = 0; i < 4; ++i) gl[i] = L[i] + F.in[IN_B_GROUP][i];
            int gs = 0; float gm = gl[0];
#pragma unroll
            for (int i = 1; i < 4; ++i) if (gl[i] > gm) { gm = gl[i]; gs = i; }
            float den = 0.f;
#pragma unroll
            for (int i = 0; i < 4; ++i) den += expf(gl[i] - gm);
            const float gwt = 1.0f / den;
            float el[8];
#pragma unroll
            for (int i = 0; i < 8; ++i) { const float a = gs == 0 ? L[4 + i] : (gs == 1 ? L[12 + i] : (gs == 2 ? L[20 + i] : L[28 + i])); el[i] = a + F.in[IN_B_ROUTER][gs * 8 + i]; }
            int i1 = 0; float v1 = el[0];
#pragma unroll
            for (int i = 1; i < 8; ++i) if (el[i] > v1) { v1 = el[i]; i1 = i; }
            int i2 = -1; float v2 = -3.0e38f;
#pragma unroll
            for (int i = 0; i < 8; ++i) if (i != i1 && el[i] > v2) { v2 = el[i]; i2 = i; }
            const float e2 = expf(v2 - v1), w1 = gwt / (1.0f + e2), w2 = gwt * e2 / (1.0f + e2);
            const int id1 = gs * 8 + i1, id2 = gs * 8 + i2;
            EID[tok * 2] = id1; EID[tok * 2 + 1] = id2; EW[tok * 2] = w1; EW[tok * 2 + 1] = w2;
            __hip_atomic_fetch_add(F.ctl + CW_CNT + id1, 1u, RLX_AGENT); __hip_atomic_fetch_add(F.ctl + CW_CNT + id2, 1u, RLX_AGENT);
        }
        LDS_WAIT();
    }
}
__device__ __forceinline__ void p7_assign(Frame& F) {
    LAS int* pst = (LAS int*)(F.lds);
    if (F.tid == 0) { int acc = 0; for (int e = 0; e < 32; ++e) { const int c = (int)__hip_atomic_load(F.ctl + CW_CNT + e, RLX_AGENT); pst[e] = acc; pst[64 + e] = c; acc += ((c + 255) >> 8) << 8; } pst[32] = acc; }
    __syncthreads();
    int* TILEE = (int*)(F.ws + SM_TILEE);
    if (F.vcu == 0 && F.tid <= MAXTILE) { const int tl = F.tid; int e = -1;
        if (tl == MAXTILE) { TILEE[MAXTILE] = pst[32] >> 8; }
        else { for (int k = 0; k < 32; ++k) if ((pst[k] >> 8) <= tl && tl < (pst[k + 1] >> 8)) e = k; TILEE[tl] = e; } }
    if (F.vcu == 0 && F.tid < 64) { int* CNT = TILEE + 192; if (F.tid < 32) { CNT[F.tid] = pst[64 + F.tid]; CNT[32 + F.tid] = pst[F.tid]; } }
    const int* EID = (const int*)(F.ws + SM_EID); const float* EW = (const float*)(F.ws + SM_EW);
    int* TSLOT = (int*)(F.ws + SM_TSLOT); int* STOK = (int*)(F.ws + SM_STOK); float* SW = (float*)(F.ws + SM_SW);
    const bf16* XN2 = (const bf16*)(F.ws + WS_B); bf16* XG = (bf16*)(F.ws + WS_XG);
    const int gw = F.vcu * NWAVES + F.wave, NGW = F.G * NWAVES;
    for (int tok = gw; tok < NTOK; tok += NGW) {
        int slot = 0;
        if (F.lane < 2) { const int e = EID[tok * 2 + F.lane]; const int p = (int)__hip_atomic_fetch_add(F.ctl + CW_CUR + e, 1u, RLX_AGENT); slot = pst[e] + p;
            STOK[slot] = tok; SW[slot] = EW[tok * 2 + F.lane]; TSLOT[tok * 2 + F.lane] = slot; }
        const int s0 = __shfl(slot, 0), s1 = __shfl(slot, 1);
        const v4u* src = (const v4u*)(XN2 + (size_t)tok * DM) + F.lane; v4u* d0 = (v4u*)(XG + (size_t)s0 * DM) + F.lane; v4u* d1 = (v4u*)(XG + (size_t)s1 * DM) + F.lane;
#pragma unroll
        for (int j = 0; j < 4; ++j) { const v4u w = src[64 * j]; d0[64 * j] = w; d1[64 * j] = w; }
    }
}
__device__ __forceinline__ void n8_moe(Frame& F) {
    const int* TILEE = (const int*)(F.ws + SM_TILEE); const int* CNT = TILEE + 192; const float* SW = (const float*)(F.ws + SM_SW);
    bf16* XG = (bf16*)(F.ws + WS_XG);
    LAS float* xs = (LAS float*)(F.lds); LAS float* hs = xs + 16384;
    const int ntiles = TILEE[MAXTILE];
    for (int item = F.vcu; item < ntiles * 32; item += F.G) {
        const int e = TILEE[item >> 5], s0 = item * 8; const int nvalid = CNT[e] - (s0 - CNT[32 + e]);
        if (nvalid <= 0) continue;
        for (int idx = F.tid; idx < 16384; idx += 512) { const int r = idx >> 11, d = idx & 2047; xs[d * 8 + r] = (r < nvalid) ? bf2f(XG[(size_t)(s0 + r) * DM + d]) : 0.f; }
        __syncthreads();
        const float* Wg = F.in[IN_W_GATE] + (size_t)e * DM * 512 + F.tid; const float* Wu = F.in[IN_W_UP] + (size_t)e * DM * 512 + F.tid;
        float ag[8], au[8];
#pragma unroll
        for (int r = 0; r < 8; ++r) { ag[r] = 0.f; au[r] = 0.f; }
        for (int d = 0; d < DM; ++d) { const float wgv = Wg[(size_t)d * 512], wuv = Wu[(size_t)d * 512]; const f32x4 x0 = *(const LAS f32x4*)(xs + d * 8), x1 = *(const LAS f32x4*)(xs + d * 8 + 4);
#pragma unroll
            for (int r = 0; r < 4; ++r) { ag[r] += x0[r] * wgv; au[r] += x0[r] * wuv; ag[4 + r] += x1[r] * wgv; au[4 + r] += x1[r] * wuv; } }
#pragma unroll
        for (int r = 0; r < 8; ++r) hs[F.tid * 8 + r] = (ag[r] / (1.0f + __expf(-ag[r]))) * au[r];
        __syncthreads();
        const float* Wd = F.in[IN_W_DOWN] + (size_t)e * 512 * DM + F.tid;
        float acc[4][8];
#pragma unroll
        for (int i = 0; i < 4; ++i)
#pragma unroll
            for (int r = 0; r < 8; ++r) acc[i][r] = 0.f;
        for (int j = 0; j < 512; ++j) { const f32x4 h0 = *(const LAS f32x4*)(hs + j * 8), h1 = *(const LAS f32x4*)(hs + j * 8 + 4);
#pragma unroll
            for (int i = 0; i < 4; ++i) { const float w = Wd[(size_t)j * DM + 512 * i];
#pragma unroll
                for (int r = 0; r < 4; ++r) { acc[i][r] += h0[r] * w; acc[i][4 + r] += h1[r] * w; } } }
#pragma unroll
        for (int r = 0; r < 8; ++r) if (r < nvalid) { const float w = SW[s0 + r];
#pragma unroll
            for (int i = 0; i < 4; ++i) XG[(size_t)(s0 + r) * DM + F.tid + 512 * i] = (bf16)f2bf(acc[i][r] * w); }
        __syncthreads();
    }
}
__device__ __forceinline__ void p10_final(Frame& F) {
    const int* TSLOT = (const int*)(F.ws + SM_TSLOT); const bf16* YD = (const bf16*)(F.ws + WS_XG); const float* gain = F.in[IN_FINAL_NORM];
    const int gw = F.vcu * NWAVES + F.wave, NGW = F.G * NWAVES;
    for (int tok = gw; tok < NTOK; tok += NGW) {
        const int s0 = TSLOT[tok * 2], s1 = TSLOT[tok * 2 + 1];
        f32x4* xr = (f32x4*)(F.out + (size_t)tok * DM) + F.lane; const f32x4* gr = (const f32x4*)gain + F.lane;
        const v2u* y0 = (const v2u*)(YD + (size_t)s0 * DM) + F.lane; const v2u* y1 = (const v2u*)(YD + (size_t)s1 * DM) + F.lane;
        f32x4 v[8]; float s = 0.f;
#pragma unroll
        for (int j = 0; j < 8; ++j) { v[j] = xr[64 * j]; const v2u a = y0[64 * j], b = y1[64 * j];
            v[j].x = (v[j].x + bflo(a.x)) + bflo(b.x); v[j].y = (v[j].y + bfhi(a.x)) + bfhi(b.x); v[j].z = (v[j].z + bflo(a.y)) + bflo(b.y); v[j].w = (v[j].w + bfhi(a.y)) + bfhi(b.y);
            s += (v[j].x * v[j].x + v[j].y * v[j].y) + (v[j].z * v[j].z + v[j].w * v[j].w); }
        const float rstd = 1.0f / sqrtf(wave_sum(s) * (1.f / DM) + EPS);
#pragma unroll
        for (int j = 0; j < 8; ++j) { const f32x4 g = gr[64 * j]; xr[64 * j] = (f32x4){v[j].x * rstd * g.x, v[j].y * rstd * g.y, v[j].z * rstd * g.z, v[j].w * rstd * g.w}; }
    }
}

constexpr int N_PHASES = 11;
#ifndef NAIVE_MOE
#define NAIVE_MOE 0
#endif
#ifndef MK_ONE_LAUNCH
#define MK_ONE_LAUNCH 1
#endif
struct Args { const float* in[22]; float* out; unsigned char* ws; int ph_lo, ph_hi; };
__global__ void __launch_bounds__(NWAVES * 64, 2) fwd(Args args) {
    extern __shared__ __attribute__((aligned(16))) unsigned char lds[];
    Frame F;
    F.lds = (LAS unsigned char*)lds;
    F.MISC = (volatile LAS unsigned*)(F.lds + MISC_OFF);
    F.tid = threadIdx.x; F.lane = F.tid & 63; F.wave = __builtin_amdgcn_readfirstlane(F.tid >> 6);
    F.G = gridDim.x; { const int bx = blockIdx.x; F.vcu = (F.G % 8 == 0) ? (bx % 8) * (F.G / 8) + bx / 8 : bx; }
#pragma unroll
    for (int i = 0; i < 22; ++i) F.in[i] = args.in[i];
    F.out = args.out; F.ws = args.ws; F.ctl = (gu32*)(args.ws + WS_CTL);
    for (int u = F.tid; u < (LDS_BYTES - LDSCTL_OFF) / 4; u += NWAVES * 64) ((LAS unsigned*)(F.lds + LDSCTL_OFF))[u] = 0u;
    __syncthreads();
    const int lo = args.ph_lo, hi = args.ph_hi;
    const bool multi = (hi - lo) > 1;
    XcdBarrier bar; bar.bar = (unsigned*)(F.ctl + CW_BAR); bar.x = 0; bar.st = nullptr;
    if (multi) bar = xcd_barrier_post((unsigned*)(F.ctl + CW_BAR), F.MISC + 8);
#ifndef PHMASK
#define PHMASK 0xFFFF
#endif
#define IN(k) (((PHMASK >> (k)) & 1) && lo <= (k) && (k) < hi)
#define SEAM(k) do { if (IN(k) && IN((k) + 1)) xcd_barrier(bar); } while (0)
    if (IN(0)) { p0_prologue(F); } SEAM(0);
    if (IN(1)) {
        pg8::Gemm g{DM, DM * 2, DM * 2, 128}; pg8::DenseOrder S; S.init(F.ws + WS_B, F.ws + WS_WINT, NTOK, LDP, DM * 2, DM * 2, F.G, (int)blockIdx.x);
        pg8::EpiBf16<0> E{(pg8::bf16_t*)(F.ws + WS_PROJ), LDP, nullptr};
        pg8::gemm_phase<pg8::EpiBf16<0>, pg8::DenseOrder, true, true>(F.lds + RING_OFF, g, S, E);
    } SEAM(1);
    if (IN(2)) { n2_rope_compress(F); } SEAM(2);
    if (IN(3)) { n3_mixers(F); } SEAM(3);
    if (IN(4)) { n4_nsanorm(F); } SEAM(4);
    if (IN(5)) {
        pg8::Gemm g{DM, DM * 2, DM * 2, 128}; pg8::DenseOrder S; S.init(F.ws + WS_B, F.ws + WS_WOT, NTOK, DM, DM * 2, DM * 2, F.G, (int)blockIdx.x);
        pg8::EpiResF32 E{F.in[IN_X], F.out, DM};
        pg8::gemm_phase<pg8::EpiResF32, pg8::DenseOrder, true, true>(F.lds + RING_OFF, g, S, E);
    } SEAM(5);
    if (IN(6)) { p6_router(F); } SEAM(6);
    if (IN(7)) { p7_assign(F); } SEAM(7);
#if NAIVE_MOE
    if (IN(8)) { n8_moe(F); } SEAM(8); SEAM(9);
#else
    if (IN(8)) {
        const int* TILEE = (const int*)(F.ws + SM_TILEE);
        pg8::Gemm g{DM, DM * 2, DM * 2, 128}; pg8::MoeOrder S; S.init(F.ws + WS_XG, F.ws + WS_WGUT, TILEE, TILEE[MAXTILE], 4, DM * 2, DM * 2, 1024, F.G, F.vcu);
        pg8::EpiSwiGLU E{(pg8::bf16_t*)(F.ws + WS_HIDM), 512};
        pg8::gemm_phase<pg8::EpiSwiGLU, pg8::MoeOrder, true, true>(F.lds + RING_OFF, g, S, E);
    } SEAM(8);
    if (IN(9)) {
        const int* TILEE = (const int*)(F.ws + SM_TILEE);
        pg8::Gemm g{512, 512 * 2, 512 * 2, 128}; pg8::MoeOrder S; S.init(F.ws + WS_HIDM, F.ws + WS_WDT, TILEE, TILEE[MAXTILE], 8, 512 * 2, 512 * 2, DM, F.G, F.vcu);
        pg8::EpiRowScaleBf16 E{(pg8::bf16_t*)(F.ws + WS_XG), DM, (const float*)(F.ws + SM_SW)};
        pg8::gemm_phase<pg8::EpiRowScaleBf16, pg8::MoeOrder, true, true>(F.lds + RING_OFF, g, S, E);
    } SEAM(9);
#endif
    if (IN(10)) { p10_final(F); }
#undef IN
#undef SEAM
}

extern "C" void kernel_launch(void* const* d_in, const int* in_sizes, int n_in, void* d_out, int out_size, void* d_ws, size_t ws_size, hipStream_t stream) {
    static int grid = 0;
    if (grid == 0) {
        if (n_in != 22 || out_size != NTOK * DM || ws_size < WS_END) { fprintf(stderr, "kernel_launch: unexpected shapes (n_in %d, out %d, ws %zu < %zu)\n", n_in, out_size, ws_size, (size_t)WS_END); grid = -1; return; }
        int dev = 0, cus = 0, per_cu = 0;
        if (hipGetDevice(&dev) != hipSuccess || hipDeviceGetAttribute(&cus, hipDeviceAttributeMultiprocessorCount, dev) != hipSuccess) { grid = -1; return; }
        if (hipFuncSetAttribute((const void*)fwd, hipFuncAttributeMaxDynamicSharedMemorySize, LDS_BYTES) != hipSuccess) { fprintf(stderr, "kernel_launch: hipFuncSetAttribute failed\n"); grid = -1; return; }
        if (hipOccupancyMaxActiveBlocksPerMultiprocessor(&per_cu, (const void*)fwd, NWAVES * 64, LDS_BYTES) != hipSuccess || per_cu < 1) { fprintf(stderr, "kernel_launch: occupancy query says %d\n", per_cu); }
        (void)hipGetLastError();
        grid = cus;
    }
    if (grid < 0) return;
    (void)hipMemsetAsync((char*)d_ws + WS_CTL, 0, CTL_ZERO_BYTES, stream);
    Args a{};
    for (int i = 0; i < 22; ++i) a.in[i] = (const float*)d_in[i];
    a.out = (float*)d_out; a.ws = (unsigned char*)d_ws;
#if MK_ONE_LAUNCH
    a.ph_lo = 0; a.ph_hi = N_PHASES;
    hipLaunchKernelGGL(fwd, dim3(grid), dim3(NWAVES * 64), LDS_BYTES, stream, a);
#else
    for (int p = 0; p < N_PHASES; ++p) { a.ph_lo = p; a.ph_hi = p + 1; hipLaunchKernelGGL(fwd, dim3(grid), dim3(NWAVES * 64), LDS_BYTES, stream, a); }
#endif
}
```

```cpp
#include <hip/hip_runtime.h>
#include <cstdio>
#include <cstdint>
namespace pg8 {
#define PG8_LAS __attribute__((address_space(3)))
typedef unsigned short bf16_t;
typedef short bf16x8 __attribute__((ext_vector_type(8)));
typedef float f32x4 __attribute__((ext_vector_type(4)));
typedef unsigned u32x4 __attribute__((ext_vector_type(4)));
constexpr int BM = 256, BK = 64, HALF = 128, HTB = HALF * BK * 2  , STAGE_BYTES = 8 * HTB, NXCD = 8, WGM = 8;

__host__ __device__ __forceinline__ int lds_byte(int r, int c) { const int st = (r >> 4) * 2 + (c >> 5), rr = r & 15, cc = c & 31, ob = rr * 64 + cc * 2; return st * 1024 + (ob ^ (((ob >> 9) & 1) << 5)); }
__host__ __device__ __forceinline__ void stage_rc(int b, int& R, int& C) { const int st = b / 1024, sb = b % 1024, swz = sb ^ (((sb >> 9) & 1) << 5); R = (st >> 1) * 16 + swz / 64; C = (st & 1) * 32 + (swz % 64) / 2; }
__host__ __device__ __forceinline__ int perm32(int rho) { const int n = rho >> 4, i = rho & 15; return 8 * (i >> 2) + 4 * n + (i & 3); }

typedef unsigned u32x2 __attribute__((ext_vector_type(2)));
struct Unit { int pm, pn; const char* a; const char* b; };
struct Gemm { int K; int lda, ldb, kstepA; };

struct DenseOrder {
    int nM, nN, nwg, G, c; const char* A; const char* B; size_t tA, tB;
    __device__ __forceinline__ void init(const void* A_, const void* B_, int M, int N, int lda, int ldb, int G_, int c_) {
        nM = M / BM; nN = N / BM; nwg = nM * nN; G = G_; c = c_; A = (const char*)A_; B = (const char*)B_; tA = (size_t)BM * lda; tB = (size_t)BM * ldb; }
    __device__ __forceinline__ bool next(int i, Unit& u) const {
        const long L = (long)i * G + c; if (L >= nwg) return false;
        int wgid = (int)L; { const int q = nwg / NXCD, r = nwg % NXCD, xcd = wgid % NXCD, off = wgid / NXCD; wgid = (xcd < r ? xcd * (q + 1) : r * (q + 1) + (xcd - r) * q) + off; }
        const int nig = WGM * nN, gid = wgid / nig, fm = gid * WGM, gsz = (nM - fm) < WGM ? (nM - fm) : WGM;
        u.pm = fm + ((wgid % nig) % gsz); u.pn = (wgid % nig) / gsz; u.a = A + (size_t)u.pm * tA; u.b = B + (size_t)u.pn * tB; return true;
    }
    __device__ __forceinline__ void a_ready(const Unit&) const {}
    __device__ __forceinline__ void done(const Unit&) const {}
};

__device__ __forceinline__ unsigned cvt_pk_bf16(float lo, float hi) { unsigned r; asm volatile("v_cvt_pk_bf16_f32 %0, %1, %2" : "=v"(r) : "v"(lo), "v"(hi)); return r; }
__device__ __forceinline__ float gelu_tanh(float x) {
    const float u = 0.7978845608f * (x + 0.044715f * x * x * x);
    return x / (1.0f + __expf(-2.0f * u));
}
template <int ACT> struct EpiBf16 {
    static constexpr bool PERM = true, AFTER_DRAIN = false;
    bf16_t* O; int ldc; const float* bias;
    __device__ __forceinline__ void operator()(const f32x4 (&acc)[2][2][4][2], const Unit& u, int wr, int wc, int fr, int fq) const {
        const int row0 = u.pm * BM + wr * 64 + fr; const int col0 = u.pn * BM + wc * 32 + 8 * fq;
        f32x4 bv[2][2];
#pragma unroll
        for (int bj = 0; bj < 2; ++bj)
#pragma unroll
            for (int n = 0; n < 2; ++n) bv[bj][n] = bias ? *(const f32x4*)(bias + col0 + bj * HALF + 4 * n) : (f32x4){0.f, 0.f, 0.f, 0.f};
#pragma unroll
        for (int ai = 0; ai < 2; ++ai)
#pragma unroll
            for (int m = 0; m < 4; ++m) { bf16_t* rowp = O + (size_t)(row0 + ai * HALF + m * 16) * ldc + col0;
#pragma unroll
                for (int bj = 0; bj < 2; ++bj) { f32x4 v0 = acc[ai][bj][m][0] + bv[bj][0], v1 = acc[ai][bj][m][1] + bv[bj][1];
                    if (ACT == 2) {
#pragma unroll
                        for (int j = 0; j < 4; ++j) { v0[j] = gelu_tanh(v0[j]); v1[j] = gelu_tanh(v1[j]); } }
                    u32x4 w; w.x = cvt_pk_bf16(v0[0], v0[1]); w.y = cvt_pk_bf16(v0[2], v0[3]); w.z = cvt_pk_bf16(v1[0], v1[1]); w.w = cvt_pk_bf16(v1[2], v1[3]);
                    *(u32x4*)(rowp + bj * HALF) = w; } }
    }
};
struct EpiResF32 {
    static constexpr bool PERM = false, AFTER_DRAIN = false;
    const float* base; float* C; int ldc;
    __device__ __forceinline__ void operator()(const f32x4 (&acc)[2][2][4][2], const Unit& u, int wr, int wc, int fr, int fq) const {
        const int row0 = u.pm * BM + wr * 64 + fr, col0 = u.pn * BM + wc * 32 + 4 * fq;
#pragma unroll
        for (int ai = 0; ai < 2; ++ai)
#pragma unroll
            for (int m = 0; m < 4; ++m) { const size_t off = (size_t)(row0 + ai * HALF + m * 16) * ldc + col0;
#pragma unroll
                for (int bj = 0; bj < 2; ++bj)
#pragma unroll
                    for (int n = 0; n < 2; ++n) { const f32x4 bs = *(const f32x4*)(base + off + bj * HALF + n * 16); *(f32x4*)(C + off + bj * HALF + n * 16) = bs + acc[ai][bj][m][n]; } }
    }
};


struct MoeOrder {
    int NC, G, c, nunits; const int* tile_e; const char* A; const char* B; size_t tA, tE, tN;
    __device__ __forceinline__ void init(const void* A_, const void* B_, const int* tile_e_, int ntiles, int NC_, int lda, int ldb, int rows_per_expert, int G_, int c_) {
        NC = NC_; G = G_; c = c_; nunits = ntiles * NC_; tile_e = tile_e_; A = (const char*)A_; B = (const char*)B_; tA = (size_t)BM * lda; tE = (size_t)rows_per_expert * ldb; tN = (size_t)BM * ldb; }
    __device__ __forceinline__ bool next(int i, Unit& u) const {
        const int L = i * G + c; if (L >= nunits) return false;
        u.pm = L / NC; u.pn = L % NC; const int e = tile_e[u.pm]; u.a = A + (size_t)u.pm * tA; u.b = B + (size_t)e * tE + (size_t)u.pn * tN; return true;
    }
    __device__ __forceinline__ void a_ready(const Unit&) const {}
    __device__ __forceinline__ void done(const Unit&) const {}
};
struct EpiSwiGLU {
    static constexpr bool PERM = true, AFTER_DRAIN = false;
    bf16_t* O; int ldc; const float* rowscale;
    __device__ __forceinline__ void operator()(const f32x4 (&acc)[2][2][4][2], const Unit& u, int wr, int wc, int fr, int fq) const {
        const int row0 = u.pm * BM + wr * 64 + fr; const int col0 = u.pn * 128 + wc * 16 + 4 * fq;
#pragma unroll
        for (int ai = 0; ai < 2; ++ai)
#pragma unroll
            for (int m = 0; m < 4; ++m) { const int row = row0 + ai * HALF + m * 16; const float rs = rowscale[row]; bf16_t* rowp = O + (size_t)row * ldc + col0;
#pragma unroll
                for (int bj = 0; bj < 2; ++bj) { const f32x4 g = acc[ai][bj][m][0] * rs, up = acc[ai][bj][m][1] * rs; float h[4];
#pragma unroll
                    for (int j = 0; j < 4; ++j) h[j] = g[j] / (1.0f + __expf(-g[j])) * up[j];
                    u32x2 w; w.x = cvt_pk_bf16(h[0], h[1]); w.y = cvt_pk_bf16(h[2], h[3]);
                    *(u32x2*)(rowp + bj * 64) = w; } }
    }
};
struct EpiRowScaleBf16 {
    static constexpr bool PERM = true, AFTER_DRAIN = false;
    bf16_t* O; int ldc; const float* rowscale;
    __device__ __forceinline__ void operator()(const f32x4 (&acc)[2][2][4][2], const Unit& u, int wr, int wc, int fr, int fq) const {
        const int row0 = u.pm * BM + wr * 64 + fr; const int col0 = u.pn * BM + wc * 32 + 8 * fq;
#pragma unroll
        for (int ai = 0; ai < 2; ++ai)
#pragma unroll
            for (int m = 0; m < 4; ++m) { const int row = row0 + ai * HALF + m * 16; const float sc = rowscale[row]; bf16_t* rowp = O + (size_t)row * ldc + col0;
#pragma unroll
                for (int bj = 0; bj < 2; ++bj) { const f32x4 v0 = acc[ai][bj][m][0] * sc, v1 = acc[ai][bj][m][1] * sc;
                    u32x4 w; w.x = cvt_pk_bf16(v0[0], v0[1]); w.y = cvt_pk_bf16(v0[2], v0[3]); w.z = cvt_pk_bf16(v1[0], v1[1]); w.w = cvt_pk_bf16(v1[2], v1[3]);
                    *(u32x4*)(rowp + bj * HALF) = w; } }
    }
};


struct CmpOrder {
    int c; const char* proj; const char* w1k; const char* w1v; size_t tokrow; int colk, colv;
    __device__ __forceinline__ bool next(int i, Unit& u) const {
        if (i != 0 || c >= 32) return false;
        const int br = c >> 4, g = (c >> 2) & 3, b = c & 3;
        u.pm = c; u.pn = 0; u.a = proj + (size_t)(b * 4096) * tokrow + (br ? colv : colk) + g * 128; u.b = br ? w1v : w1k; return true;
    }
    __device__ __forceinline__ void a_ready(const Unit&) const {}
    __device__ __forceinline__ void done(const Unit&) const {}
};
struct EpiCmp {
    static constexpr bool PERM = true, AFTER_DRAIN = false;
    bf16_t* O; const float* biask; const float* biasv;
    __device__ __forceinline__ void operator()(const f32x4 (&acc)[2][2][4][2], const Unit& u, int wr, int wc, int fr, int fq) const {
        const int row0 = u.pm * BM + wr * 64 + fr; const int col0 = wc * 32 + 8 * fq; const float* bias = (u.pm >= 16) ? biasv : biask;
        f32x4 bv[2][2];
#pragma unroll
        for (int bj = 0; bj < 2; ++bj)
#pragma unroll
            for (int n = 0; n < 2; ++n) bv[bj][n] = *(const f32x4*)(bias + col0 + bj * HALF + 4 * n);
#pragma unroll
        for (int ai = 0; ai < 2; ++ai)
#pragma unroll
            for (int m = 0; m < 4; ++m) { bf16_t* rowp = O + (size_t)(row0 + ai * HALF + m * 16) * 256 + col0;
#pragma unroll
                for (int bj = 0; bj < 2; ++bj) { f32x4 v0 = acc[ai][bj][m][0] + bv[bj][0], v1 = acc[ai][bj][m][1] + bv[bj][1];
#pragma unroll
                    for (int j = 0; j < 4; ++j) { v0[j] = gelu_tanh(v0[j]); v1[j] = gelu_tanh(v1[j]); }
                    u32x4 w; w.x = cvt_pk_bf16(v0[0], v0[1]); w.y = cvt_pk_bf16(v0[2], v0[3]); w.z = cvt_pk_bf16(v1[0], v1[1]); w.w = cvt_pk_bf16(v1[2], v1[3]);
                    *(u32x4*)(rowp + bj * HALF) = w; } }
    }
};

template <class Epi, class Sched, bool ALIGN_EPI = false, bool SP2 = false>
__device__ __forceinline__ void gemm_phase(PG8_LAS unsigned char* lds, const Gemm g, const Sched& S, const Epi& E) {
    const int tid = threadIdx.x, wid = __builtin_amdgcn_readfirstlane(tid >> 6), lane = tid & 63, wr = wid >> 2, wc = wid & 3, fr = lane & 15, fq = lane >> 4;
    const int K = g.K, nt = K / BK;
    unsigned voffA[2], voffB[2];
#pragma unroll
    for (int i = 0; i < 2; ++i) { int R, C; stage_rc(tid * 16 + i * 8192, R, C); const int Rb = Epi::PERM ? ((R & ~31) + perm32(R & 31)) : R;
        voffA[i] = (unsigned)(R * g.lda + C * 2); voffB[i] = (unsigned)(Rb * g.ldb + C * 2); }
    const size_t kstepA = (size_t)g.kstepA, kstepB = (size_t)(BK * 2);
    const size_t hstepA = (size_t)HALF * g.lda, hstepB = (size_t)HALF * g.ldb;
    const unsigned ldsw = (unsigned)wid * 1024u;
    const int aoff = lds_byte(wr * 64 + fr, fq * 8), boff = lds_byte(wc * 32 + fr, fq * 8);
#define PG8_SA(b, h) (((b) * 2 + (h)) * HTB)
#define PG8_SB(b, h) ((4 + (b) * 2 + (h)) * HTB)
#define PG8_STAGE(bufoff, gbase, voff) do { _Pragma("unroll") for (int _i = 0; _i < 2; ++_i) \
        __builtin_amdgcn_global_load_lds((const unsigned*)((const char*)(gbase) + (voff)[_i]), (PG8_LAS unsigned*)(lds + (bufoff) + ldsw + _i * 8192), 16, 0, 0); } while (0)
#define PG8_LDA(dst, b, h) do { _Pragma("unroll") for (int m = 0; m < 4; ++m) _Pragma("unroll") for (int k = 0; k < 2; ++k) dst[m][k] = *(const PG8_LAS bf16x8*)(lds + PG8_SA(b, h) + aoff + m * 2048 + k * 1024); } while (0)
#define PG8_LDB(dst, b, h) do { _Pragma("unroll") for (int n = 0; n < 2; ++n) _Pragma("unroll") for (int k = 0; k < 2; ++k) dst[n][k] = *(const PG8_LAS bf16x8*)(lds + PG8_SB(b, h) + boff + n * 2048 + k * 1024); } while (0)
#define PG8_MMA(ai, bj, At, Bt) do { __builtin_amdgcn_s_setprio(1); _Pragma("unroll") for (int m = 0; m < 4; ++m) _Pragma("unroll") for (int n = 0; n < 2; ++n) _Pragma("unroll") for (int k = 0; k < 2; ++k) \
        acc[ai][bj][m][n] = __builtin_amdgcn_mfma_f32_16x16x32_bf16(Bt[n][k], At[m][k], acc[ai][bj][m][n], 0, 0, 0); __builtin_amdgcn_s_setprio(0); } while (0)
#define PG8_WAIT_V(n) asm volatile("s_waitcnt vmcnt(" #n ")" ::: "memory")
#define PG8_WAIT_L(n) asm volatile("s_waitcnt lgkmcnt(" #n ")" ::: "memory")
#define PG8_BAR __builtin_amdgcn_s_barrier()
#define PG8_SCHED __builtin_amdgcn_sched_barrier(0)
    Unit cur, nxt; int ui = 0;
    if (!S.next(0, cur)) return;
    f32x4 acc[2][2][4][2];
#pragma unroll
    for (int a = 0; a < 2; ++a)
#pragma unroll
        for (int b = 0; b < 2; ++b)
#pragma unroll
            for (int m = 0; m < 4; ++m)
#pragma unroll
                for (int n = 0; n < 2; ++n) acc[a][b][m][n] = (f32x4){0.f, 0.f, 0.f, 0.f};
    bf16x8 At[4][2], B0[2][2], B1[2][2];
    const char* cA = cur.a; const char* cB = cur.b;
    S.a_ready(cur);
    if constexpr (SP2) {
        PG8_STAGE(PG8_SB(0, 0), cB, voffB); PG8_STAGE(PG8_SB(0, 1), cB + hstepB, voffB); PG8_STAGE(PG8_SA(0, 0), cA, voffA); PG8_STAGE(PG8_SA(0, 1), cA + hstepA, voffA);
        if (wr == 1) PG8_BAR;
        PG8_WAIT_V(2); PG8_BAR;
        PG8_STAGE(PG8_SB(1, 0), cB + kstepB, voffB); PG8_STAGE(PG8_SA(1, 0), cA + kstepA, voffA); PG8_STAGE(PG8_SB(1, 1), cB + hstepB + kstepB, voffB);
        PG8_WAIT_V(6); PG8_BAR;
    } else {
        PG8_STAGE(PG8_SB(0, 0), cB, voffB); PG8_STAGE(PG8_SA(0, 0), cA, voffA); PG8_STAGE(PG8_SB(0, 1), cB + hstepB, voffB); PG8_STAGE(PG8_SA(0, 1), cA + hstepA, voffA);
        if (wr == 1) PG8_BAR;
        PG8_WAIT_V(4); PG8_BAR;
        PG8_STAGE(PG8_SB(1, 0), cB + kstepB, voffB); PG8_STAGE(PG8_SA(1, 0), cA + kstepA, voffA); PG8_STAGE(PG8_SB(1, 1), cB + hstepB + kstepB, voffB);
        PG8_WAIT_V(6); PG8_BAR;
    }
    for (;;) {
        const bool has_next = S.next(ui + 1, nxt);
        const char* nA = has_next ? nxt.a : cA; const char* nB = has_next ? nxt.b : cB;
        for (int t = 0; t < nt; t += 2) {
            const bool last = (t == nt - 2);
            const char* a1 = cA + (size_t)(t + 1) * kstepA;
            const char* a2 = last ? nA : cA + (size_t)(t + 2) * kstepA; const char* b2 = last ? nB : cB + (size_t)(t + 2) * kstepB;
            const char* a3 = a2 + kstepA; const char* b3 = b2 + kstepB;
            if (last && has_next) S.a_ready(nxt);
            if constexpr (SP2) {
            PG8_LDB(B0, 0, 0); PG8_LDB(B1, 0, 1); PG8_SCHED; PG8_LDA(At, 0, 0); PG8_STAGE(PG8_SA(1, 1), a1 + hstepA, voffA);
            PG8_WAIT_V(8); PG8_WAIT_L(0); PG8_BAR; PG8_MMA(0, 0, At, B0); PG8_MMA(0, 1, At, B1); PG8_BAR; PG8_SCHED;
            PG8_LDA(At, 0, 1); PG8_STAGE(PG8_SB(0, 0), b2, voffB); PG8_STAGE(PG8_SB(0, 1), b2 + hstepB, voffB); PG8_STAGE(PG8_SA(0, 0), a2, voffA);
            PG8_WAIT_V(8); PG8_WAIT_L(0); PG8_BAR; PG8_MMA(1, 0, At, B0); PG8_MMA(1, 1, At, B1); PG8_BAR; PG8_SCHED;
            PG8_LDB(B0, 1, 0); PG8_LDB(B1, 1, 1); PG8_SCHED; PG8_LDA(At, 1, 0); PG8_STAGE(PG8_SA(0, 1), a2 + hstepA, voffA);
            PG8_WAIT_V(8); PG8_WAIT_L(0); PG8_BAR; PG8_MMA(0, 0, At, B0); PG8_MMA(0, 1, At, B1); PG8_BAR; PG8_SCHED;
            PG8_LDA(At, 1, 1); PG8_STAGE(PG8_SB(1, 0), b3, voffB); PG8_STAGE(PG8_SB(1, 1), b3 + hstepB, voffB); PG8_STAGE(PG8_SA(1, 0), a3, voffA);
            PG8_WAIT_V(8); PG8_WAIT_L(0); PG8_BAR; PG8_MMA(1, 0, At, B0); PG8_MMA(1, 1, At, B1); PG8_BAR; PG8_SCHED;
            } else {
            PG8_LDB(B0, 0, 0); PG8_SCHED; PG8_LDA(At, 0, 0); PG8_STAGE(PG8_SA(1, 1), a1 + hstepA, voffA);
            PG8_WAIT_L(8); PG8_BAR; PG8_WAIT_L(0); PG8_MMA(0, 0, At, B0); PG8_BAR; PG8_SCHED;
            PG8_LDB(B1, 0, 1); PG8_STAGE(PG8_SB(0, 0), b2, voffB);
            PG8_BAR; PG8_WAIT_L(0); PG8_MMA(0, 1, At, B1); PG8_BAR;
            PG8_LDA(At, 0, 1); PG8_STAGE(PG8_SA(0, 0), a2, voffA);
            PG8_BAR; PG8_WAIT_L(0); PG8_MMA(1, 0, At, B0); PG8_BAR; PG8_SCHED;
            PG8_STAGE(PG8_SB(0, 1), b2 + hstepB, voffB);
            PG8_WAIT_V(6); PG8_BAR; PG8_MMA(1, 1, At, B1); PG8_BAR;
            PG8_LDB(B0, 1, 0); PG8_SCHED; PG8_LDA(At, 1, 0); PG8_STAGE(PG8_SA(0, 1), a2 + hstepA, voffA);
            PG8_WAIT_L(8); PG8_BAR; PG8_WAIT_L(0); PG8_MMA(0, 0, At, B0); PG8_BAR; PG8_SCHED;
            PG8_LDB(B1, 1, 1); PG8_STAGE(PG8_SB(1, 0), b3, voffB);
            PG8_BAR; PG8_WAIT_L(0); PG8_MMA(0, 1, At, B1); PG8_BAR;
            PG8_LDA(At, 1, 1); PG8_STAGE(PG8_SA(1, 0), a3, voffA);
            PG8_BAR; PG8_WAIT_L(0); PG8_MMA(1, 0, At, B0); PG8_BAR; PG8_SCHED;
            PG8_STAGE(PG8_SB(1, 1), b3 + hstepB, voffB);
            PG8_WAIT_V(6); PG8_BAR; PG8_MMA(1, 1, At, B1); PG8_BAR;
            }
        }
        if constexpr (ALIGN_EPI) { if (wr == 0) PG8_BAR; }
        if constexpr (!Epi::AFTER_DRAIN) { E(acc, cur, wr, wc, fr, fq); S.done(cur); }
        if (!has_next) break;
#pragma unroll
        for (int a = 0; a < 2; ++a)
#pragma unroll
            for (int b = 0; b < 2; ++b)
#pragma unroll
                for (int m = 0; m < 4; ++m)
#pragma unroll
                    for (int n = 0; n < 2; ++n) acc[a][b][m][n] = (f32x4){0.f, 0.f, 0.f, 0.f};
        cur = nxt; cA = nA; cB = nB; ++ui;
        if constexpr (ALIGN_EPI) { if (wr == 1) PG8_BAR; }
    }
    PG8_WAIT_V(0);
    if constexpr (!ALIGN_EPI) { if (wr == 0) PG8_BAR; }
    PG8_BAR;
    if constexpr (Epi::AFTER_DRAIN) { E.fused(acc, cur, wr, wc, fr, fq, lds, wid, lane); S.done(cur); }
#undef PG8_SA
#undef PG8_SB
#undef PG8_STAGE
#undef PG8_LDA
#undef PG8_LDB
#undef PG8_MMA
#undef PG8_WAIT_V
#undef PG8_WAIT_L
#undef PG8_BAR
#undef PG8_SCHED
}
}

#define GAS __attribute__((address_space(1)))
#define LAS __attribute__((address_space(3)))
typedef unsigned short bf16;
typedef unsigned v4u __attribute__((ext_vector_type(4)));
typedef unsigned v2u __attribute__((ext_vector_type(2)));
typedef float f32x4 __attribute__((ext_vector_type(4)));
typedef float f32x16 __attribute__((ext_vector_type(16)));
typedef short bf16x8 __attribute__((ext_vector_type(8)));
typedef short s16x4 __attribute__((ext_vector_type(4)));
typedef GAS unsigned gu32;
#define RLX_AGENT __ATOMIC_RELAXED, __HIP_MEMORY_SCOPE_AGENT
#define LDS_WAIT() asm volatile("s_waitcnt lgkmcnt(0)" ::: "memory")
#define VM_WAIT() asm volatile("s_waitcnt vmcnt(0)" ::: "memory")
__device__ __forceinline__ unsigned f2bf(float f) { unsigned u = __builtin_bit_cast(unsigned, f); return (u + 0x7fffu + ((u >> 16) & 1u)) >> 16; }
__device__ __forceinline__ unsigned pk2(float lo, float hi) { return f2bf(lo) | (f2bf(hi) << 16); }
__device__ __forceinline__ float bf2f(unsigned b) { return __builtin_bit_cast(float, b << 16); }
__device__ __forceinline__ float bflo(unsigned w) { return __builtin_bit_cast(float, w << 16); }
__device__ __forceinline__ float bfhi(unsigned w) { return __builtin_bit_cast(float, w & 0xffff0000u); }
__device__ __forceinline__ float wave_sum(float v) {
#pragma unroll
    for (int o = 1; o < 64; o <<= 1) v += __shfl_xor(v, o);
    return v;
}
__device__ __forceinline__ float wave_max(float v) {
#pragma unroll
    for (int o = 1; o < 64; o <<= 1) v = fmaxf(v, __shfl_xor(v, o));
    return v;
}

#define XB_TMO      128
#define XB_XCNT(j)  (256  + 64 * (j))
#define XB_XSUB(j)  (1280 + 64 * (j))
#define XB_XGEN(j)  (2304 + 64 * (j))
#define XB_TOP      3328
#define XB_TOPGEN   3392
#define XCD_BAR_WORDS 3456
#define XB_SPIN_CAP (1u << 18)

__device__ __forceinline__ unsigned xb_ld(unsigned* p)              { return __hip_atomic_load(p, __ATOMIC_RELAXED, __HIP_MEMORY_SCOPE_AGENT); }
__device__ __forceinline__ unsigned xb_add(unsigned* p, unsigned v) { return __hip_atomic_fetch_add(p, v, __ATOMIC_RELAXED, __HIP_MEMORY_SCOPE_AGENT); }
__device__ __forceinline__ unsigned xb_xcc_id() { return (unsigned)__builtin_amdgcn_s_getreg((3 << 11) | 20) & 0xFu; }
#define XB_SPIN(cond, bar) do { unsigned _sp = 0; while (cond) { __builtin_amdgcn_s_sleep(1); \
    if ((++_sp & 255u) == 0u) { if (xb_ld(&(bar)[XB_TMO])) break; if (_sp > XB_SPIN_CAP) { atomicAdd(&(bar)[XB_TMO], 1u); break; } } } } while (0)

struct XcdBarrier {
    unsigned* bar; unsigned x;
    volatile LAS unsigned* st;
};

__device__ __forceinline__ XcdBarrier xcd_barrier_post(unsigned* bar, volatile LAS unsigned* st) {
    XcdBarrier b; b.bar = bar; b.x = xb_xcc_id(); b.st = st;
    if (threadIdx.x == 0) (void)xb_add(&bar[XB_XCNT(b.x)], 1u);
    return b;
}
__device__ __forceinline__ void xcd_barrier_complete(unsigned* bar, unsigned x, unsigned& nloc, unsigned& nx) {
    const unsigned G = gridDim.x * gridDim.y * gridDim.z;
    unsigned sum, cnt, mine, sp = 0u;
    for (;;) {
        sum = 0u; cnt = 0u; mine = 0u;
#pragma unroll
        for (unsigned j = 0; j < 16; ++j) { const unsigned c = xb_ld(&bar[XB_XCNT(j)]); sum += c; cnt += (c > 0u) ? 1u : 0u; mine = (j == x) ? c : mine; }
        if (sum == G) break;
        __builtin_amdgcn_s_sleep(1);
        if ((++sp & 255u) == 0u) { if (xb_ld(&bar[XB_TMO])) break; if (sp > XB_SPIN_CAP) { atomicAdd(&bar[XB_TMO], 1u); break; } }
    }
    nloc = mine > 0u ? mine : 1u; nx = cnt > 0u ? cnt : 1u;
}

__device__ __forceinline__ void xcd_barrier(const XcdBarrier& b) {
    asm volatile("s_waitcnt vmcnt(0)" ::: "memory");
    __syncthreads();
    if (threadIdx.x == 0) {
        unsigned* bar = b.bar;
        __builtin_amdgcn_s_waitcnt(0);
        unsigned nloc = b.st[0], nx = b.st[1];
        if (nloc == 0u) { xcd_barrier_complete(bar, b.x, nloc, nx); b.st[0] = nloc; b.st[1] = nx; }
        const unsigned old = xb_add(&bar[XB_XSUB(b.x)], 1u);
        const unsigned gen = old / nloc;
        if (old + 1u == (gen + 1u) * nloc) {
            __builtin_amdgcn_fence(__ATOMIC_RELEASE, "agent");
            asm volatile("s_waitcnt vmcnt(0)" ::: "memory");
            const unsigned og = xb_add(&bar[XB_TOP], 1u);
            const unsigned tg = og / nx;
            if (og + 1u == (tg + 1u) * nx) xb_add(&bar[XB_TOPGEN], 1u);
            else XB_SPIN(xb_ld(&bar[XB_TOPGEN]) == tg, bar);
            __builtin_amdgcn_fence(__ATOMIC_ACQUIRE, "agent");
            xb_add(&bar[XB_XGEN(b.x)], 1u);
            asm volatile("s_waitcnt vmcnt(0)" ::: "memory");
        } else {
            XB_SPIN(xb_ld(&bar[XB_XGEN(b.x)]) == gen, bar);
            __builtin_amdgcn_fence(__ATOMIC_ACQUIRE, "agent");
            asm volatile("s_waitcnt vmcnt(0)" ::: "memory");
        }
    }
    __syncthreads();
}

#ifndef NAIVE_CMP
#define NAIVE_CMP 0
#endif
#ifndef NAIVE_ATTN
#define NAIVE_ATTN 0
#endif
#ifndef NAIVE_HGRN
#define NAIVE_HGRN 0
#endif
#ifndef NAIVE_MOE
#define NAIVE_MOE 0
#endif
#ifndef ATT_PARTS
#define ATT_PARTS 7
#endif
#ifndef MK_ONE_LAUNCH
#define MK_ONE_LAUNCH 1
#endif
#ifndef DUP
#define DUP -1
#endif
#ifndef PHMASK
#define PHMASK 0xFFFF
#endif

constexpr int NWAVES = 8;
constexpr int NTOK = 16384, SEQ = 4096, DM = 2048;
constexpr int LDP = 6912;
constexpr int C_HQ = 0, C_HF = 1024, C_HI = 2048, C_HG = 3072, C_NQ = 4096, C_KC = 5120, C_VC = 5376, C_KS = 5632, C_VS = 5888, C_KW = 6144, C_VW = 6400, C_GR = 6656, IN_COLS = 6704;
constexpr float EPS = 1e-6f;
constexpr int MAXSLOT = 40960;
constexpr int MAXTILE = MAXSLOT / 256;

constexpr size_t MiB = 1u << 20;
constexpr size_t WS_CTL = 0, CTL_ZERO_BYTES = 1 * MiB;
constexpr size_t WS_SM = 1 * MiB;
constexpr size_t SM_LB = WS_SM + 0, SM_B1K = WS_SM + 4096, SM_B1V = WS_SM + 8192, SM_W2KT = WS_SM + 16384, SM_W2VT = WS_SM + 49152;
constexpr size_t SM_COS = WS_SM + 128 * 1024, SM_SIN = SM_COS + 512 * 1024;
constexpr size_t SM_W1KT = WS_SM + 2 * MiB, SM_W1VT = WS_SM + 3 * MiB;
constexpr size_t SM_EID = WS_SM + 5 * MiB, SM_EW = SM_EID + 128 * 1024, SM_TSLOT = SM_EW + 128 * 1024, SM_STOK = SM_TSLOT + 128 * 1024, SM_SW = SM_STOK + 160 * 1024, SM_TILEE = SM_SW + 160 * 1024;
constexpr size_t SM_RTH = WS_SM + 4 * MiB, SM_RTL = SM_RTH + 256 * 1024, SM_RSTD = SM_RTL + 256 * 1024, SM_SRS = SM_RSTD + 128 * 1024;
constexpr size_t SM_BPART = SM_SRS + 192 * 1024;
constexpr size_t WS_HIDC = WS_SM + 6 * MiB;
constexpr size_t WS_KC = 11 * MiB, WS_VC = 11 * MiB + 512 * 1024;
constexpr size_t WS_WINT = 12 * MiB;
constexpr size_t WS_WOT = 39 * MiB;
constexpr size_t WS_B = 47 * MiB;
constexpr size_t WS_PROJ = 111 * MiB;
constexpr size_t WS_WGUT = WS_PROJ, WS_HIDM = WS_PROJ + 128 * MiB;
constexpr size_t WS_D = 328 * MiB;
constexpr size_t WS_OI = WS_D, WS_U = WS_D + 32 * MiB, WS_DD = WS_D + 96 * MiB, WS_ONSA = WS_D + 97 * MiB;
constexpr size_t WS_SP = WS_D + 161 * MiB;
constexpr size_t WS_WDT = WS_D, WS_XG = WS_D + 64 * MiB;
constexpr size_t WS_END = WS_D + 226 * MiB;
static_assert(WS_END <= 584 * MiB, "workspace map");
constexpr int CW_TMO = 0, CW_CODE = 1, CW_BAR = 4096, CW_CNT = 8192, CW_CUR = 8192 + 64, CW_HQ = 8192 + 128;

constexpr int RING_OFF = 0, RING_BYTES = 131072;
constexpr int LDSCTL_OFF = RING_BYTES, MISC_OFF = LDSCTL_OFF + 320;
constexpr int LDS_BYTES = 147456;

struct Frame {
    LAS unsigned char* lds;
    volatile LAS unsigned* MISC;
    gu32* ctl;
    int tid, lane, wave, vcu, G;
    const float* in[22]; float* out; unsigned char* ws;
};
#define IN_X 0
#define IN_ATTN_NORM 1
#define IN_W_IN 2
#define IN_LB 3
#define IN_HG_NORM 4
#define IN_POS_K 5
#define IN_W1_K 6
#define IN_W2_K 7
#define IN_POS_V 8
#define IN_W1_V 9
#define IN_W2_V 10
#define IN_NSA_NORM 11
#define IN_W_OUT 12
#define IN_FFN_NORM 13
#define IN_W_GROUP 14
#define IN_B_GROUP 15
#define IN_W_ROUTER 16
#define IN_B_ROUTER 17
#define IN_W_GATE 18
#define IN_W_UP 19
#define IN_W_DOWN 20
#define IN_FINAL_NORM 21

__device__ __forceinline__ void transpose_item(const float* W, int ldn, int Nvalid, bf16* WT, int Kd, LAS float* scr, int k0, int n0, int lane, int ilv = -1) {
    f32x4 v[8]; const int nq = (lane & 7) * 4;
#pragma unroll
    for (int i = 0; i < 8; ++i) { const int kk = 8 * i + (lane >> 3); v[i] = (n0 + nq < Nvalid) ? *(const f32x4*)(W + (size_t)(k0 + kk) * ldn + n0 + nq) : (f32x4){0.f, 0.f, 0.f, 0.f}; }
#pragma unroll
    for (int i = 0; i < 8; ++i) { LAS float* s = scr + (8 * i + (lane >> 3)) * 33 + nq; s[0] = v[i].x; s[1] = v[i].y; s[2] = v[i].z; s[3] = v[i].w; }
    LDS_WAIT();
    const int c = lane & 7;
#pragma unroll
    for (int j = 0; j < 4; ++j) { const int n = (lane >> 3) + 8 * j; const LAS float* s = scr + (8 * c) * 33 + n;
        v4u o; o.x = pk2(s[0 * 33], s[1 * 33]); o.y = pk2(s[2 * 33], s[3 * 33]); o.z = pk2(s[4 * 33], s[5 * 33]); o.w = pk2(s[6 * 33], s[7 * 33]);
        const int nn = n0 + n; const int drow = (ilv < 0) ? nn : (8 * (nn >> 2) + (nn & 3) + ilv);
        *(v4u*)(WT + (size_t)drow * Kd + k0 + 8 * c) = o; }
    LDS_WAIT();
}
__device__ __forceinline__ void rms_row_to_bf16(const float* xrow, const float* gain, bf16* orow, int lane) {
    const f32x4* xr = (const f32x4*)xrow + lane; const f32x4* gr = (const f32x4*)gain + lane;
    f32x4 v[8]; float s = 0.f;
#pragma unroll
    for (int j = 0; j < 8; ++j) { v[j] = xr[64 * j]; s += (v[j].x * v[j].x + v[j].y * v[j].y) + (v[j].z * v[j].z + v[j].w * v[j].w); }
    const float rstd = 1.0f / sqrtf(wave_sum(s) * (1.f / DM) + EPS);
    unsigned long long* o8 = (unsigned long long*)orow + lane;
#pragma unroll
    for (int j = 0; j < 8; ++j) { const f32x4 g = gr[64 * j]; o8[64 * j] = (unsigned long long)pk2(v[j].x * rstd * g.x, v[j].y * rstd * g.y) | ((unsigned long long)pk2(v[j].z * rstd * g.z, v[j].w * rstd * g.w) << 32); }
}
__device__ __forceinline__ void p0_prologue(Frame& F) {
    LAS float* scr = (LAS float*)(F.lds + RING_OFF + F.wave * 16384);
    const int gw = F.vcu * NWAVES + F.wave, NGW = F.G * NWAVES;
    constexpr int I_IN = 32 * (LDP / 32), I_O = 32 * 64, I_W1 = 32 * 8, I_W2 = 4 * 2;
    constexpr int NITEMS = I_IN + I_O + 2 * I_W1 + 2 * I_W2;
    for (int it = gw; it < NITEMS; it += NGW) {
        int r = it;
        if (r < I_IN) { const int nblk = LDP / 32; transpose_item(F.in[IN_W_IN], IN_COLS, IN_COLS, (bf16*)(F.ws + WS_WINT), DM, scr, 64 * (r / nblk), 32 * (r % nblk), F.lane); continue; } r -= I_IN;
        if (r < I_O) { transpose_item(F.in[IN_W_OUT], DM, DM, (bf16*)(F.ws + WS_WOT), DM, scr, 64 * (r / 64), 32 * (r % 64), F.lane); continue; } r -= I_O;
        if (r < I_W1) { transpose_item(F.in[IN_W1_K], 256, 256, (bf16*)(F.ws + SM_W1KT), 2048, scr, 64 * (r / 8), 32 * (r % 8), F.lane); continue; } r -= I_W1;
        if (r < I_W1) { transpose_item(F.in[IN_W1_V], 256, 256, (bf16*)(F.ws + SM_W1VT), 2048, scr, 64 * (r / 8), 32 * (r % 8), F.lane); continue; } r -= I_W1;
        if (r < I_W2) { transpose_item(F.in[IN_W2_K], 64, 64, (bf16*)(F.ws + SM_W2KT), 256, scr, 64 * (r / 2), 32 * (r % 2), F.lane); continue; } r -= I_W2;
        transpose_item(F.in[IN_W2_V], 64, 64, (bf16*)(F.ws + SM_W2VT), 256, scr, 64 * (r / 2), 32 * (r % 2), F.lane);
    }
    bf16* H = (bf16*)(F.ws + WS_B);
    for (int m = gw; m < NTOK; m += NGW) rms_row_to_bf16(F.in[IN_X] + (size_t)m * DM, F.in[IN_ATTN_NORM], H + (size_t)m * DM, F.lane);
    const int gt = F.vcu * (NWAVES * 64) + F.tid, NT = F.G * NWAVES * 64;
    float* LB = (float*)(F.ws + SM_LB);
    for (int i = gt; i < 1024; i += NT) { const float a0 = F.in[IN_LB][i], a1 = F.in[IN_LB][1024 + i]; LB[i] = 1.0f / (1.0f + expf(a1 - a0)); }
    float* COS = (float*)(F.ws + SM_COS); float* SIN = (float*)(F.ws + SM_SIN);
    for (int i = gt; i < SEQ * 32; i += NT) { const int t = i >> 5, k = i & 31;
        const double inv = exp2(-(double)k * (13.287712379549449 / 32.0));
        double rev = (double)t * inv * 0.15915494309189535; rev -= rint(rev);
        COS[i] = __builtin_amdgcn_cosf((float)rev); SIN[i] = __builtin_amdgcn_sinf((float)rev); }
    {   float* BP = (float*)(F.ws + SM_BPART);
        for (int it = gw; it < 256; it += NGW) { const int br = it >> 7, ch = (it >> 2) & 31, j = (it & 3) * 64 + F.lane; const float* pos = F.in[br ? IN_POS_V : IN_POS_K] + ch * 64; const float* w1 = F.in[br ? IN_W1_V : IN_W1_K] + (size_t)(ch * 64) * 256 + j;
            float a[8];
#pragma unroll
            for (int u = 0; u < 8; ++u) a[u] = 0.f;
#pragma unroll
            for (int k = 0; k < 64; k += 8) {
#pragma unroll
                for (int u = 0; u < 8; ++u) a[u] += pos[k + u] * w1[(size_t)(k + u) * 256]; }
            BP[(br * 32 + ch) * 256 + j] = ((a[0] + a[1]) + (a[2] + a[3])) + ((a[4] + a[5]) + (a[6] + a[7])); } }
    {   bf16* RTH = (bf16*)(F.ws + SM_RTH); bf16* RTL = (bf16*)(F.ws + SM_RTL);
        for (int i = gt; i < 48 * DM; i += NT) { const int j = i >> 11, dd = i & (DM - 1);
            float wv = 0.f; if (j < 4) wv = F.in[IN_W_GROUP][dd * 4 + j]; else if (j < 36) wv = F.in[IN_W_ROUTER][dd * 32 + (j - 4)];
            wv *= F.in[IN_FFN_NORM][dd]; const unsigned hi = f2bf(wv); RTH[i] = (bf16)hi; RTL[i] = (bf16)f2bf(wv - bf2f(hi)); } }
    unsigned* pad = (unsigned*)((bf16*)(F.ws + WS_PROJ) + (size_t)NTOK * LDP);
    for (int i = gt; i < 16 * LDP / 2; i += NT) pad[i] = 0u;
}

__device__ __forceinline__ void n2_rope_compress(Frame& F) {
    bf16* PROJ = (bf16*)(F.ws + WS_PROJ);
    const float* COS = (const float*)(F.ws + SM_COS); const float* SIN = (const float*)(F.ws + SM_SIN);
    const int gt = F.vcu * (NWAVES * 64) + F.tid, NT = F.G * NWAVES * 64;
    for (int idx = gt; idx < NTOK * 256; idx += NT) { const int i = idx & 31, g = (idx >> 5) & 3, ten = (idx >> 7) & 1, tok = idx >> 8, pos = tok & (SEQ - 1);
        bf16* p = PROJ + (size_t)tok * LDP + (ten ? C_KW : C_KS) + g * 64 + i;
        const float a = bf2f(p[0]), b = bf2f(p[32]), c = COS[pos * 32 + i], s = SIN[pos * 32 + i];
        p[0] = (bf16)f2bf(a * c - b * s); p[32] = (bf16)f2bf(b * c + a * s); }
#if NAIVE_CMP
    LAS float* scr = (LAS float*)(F.lds + RING_OFF + F.wave * 16384);
    const int gw = F.vcu * NWAVES + F.wave, NGW = F.G * NWAVES;
    for (int it = gw; it < 2 * 4080; it += NGW) {
        const int br = it / 4080; int r = it % 4080; const int b = r / 1020; r %= 1020; const int c = r >> 2, g = r & 3;
        const float* pos = F.in[br ? IN_POS_V : IN_POS_K]; const float* w1 = F.in[br ? IN_W1_V : IN_W1_K]; const float* w2 = F.in[br ? IN_W2_V : IN_W2_K];
        const bf16* src = PROJ + (size_t)(b * SEQ + c * 16) * LDP + (br ? C_VC : C_KC) + g * 64;
        for (int k = F.lane; k < 2048; k += 64) scr[k] = bf2f(src[(size_t)(k >> 6) * LDP + (k & 63)]) + pos[k];
        LDS_WAIT();
        float a0 = 0.f, a1 = 0.f, a2 = 0.f, a3 = 0.f;
        for (int k = 0; k < 2048; ++k) { const float f = scr[k]; const float* w = w1 + (size_t)k * 256 + F.lane; a0 += f * w[0]; a1 += f * w[64]; a2 += f * w[128]; a3 += f * w[192]; }
        scr[2048 + F.lane] = pg8::gelu_tanh(a0); scr[2048 + 64 + F.lane] = pg8::gelu_tanh(a1); scr[2048 + 128 + F.lane] = pg8::gelu_tanh(a2); scr[2048 + 192 + F.lane] = pg8::gelu_tanh(a3);
        LDS_WAIT();
        float o = 0.f;
        for (int j = 0; j < 256; ++j) o += scr[2048 + j] * w2[j * 64 + F.lane];
        ((bf16*)(F.ws + (br ? WS_VC : WS_KC)))[((size_t)(b * 256 + c) * 4 + g) * 64 + F.lane] = (bf16)f2bf(o);
        LDS_WAIT();
    }
#endif
}

__device__ __forceinline__ void n3_hgrn(Frame& F, int bh) {
    const int b = bh >> 3, h = bh & 7;
    const bf16* PROJ = (const bf16*)(F.ws + WS_PROJ); bf16* Y = (bf16*)(F.ws + WS_B);
    const float* LB = (const float*)(F.ws + SM_LB); const float* gain = F.in[IN_HG_NORM];
    LAS float* qs = (LAS float*)(F.lds); LAS float* fs = qs + 2048; LAS float* is = fs + 2048; LAS float* po = is + 2048;
    const int v = F.tid & 127, kq = F.tid >> 7;
    float S[32];
#pragma unroll
    for (int i = 0; i < 32; ++i) S[i] = 0.f;
    for (int blk = 0; blk < SEQ / 16; ++blk) {
        const int t0 = blk * 16;
        for (int e = F.tid; e < 2048; e += 512) { const int s = e >> 7, k = e & 127; const bf16* row = PROJ + (size_t)(b * SEQ + t0 + s) * LDP + h * 128 + k;
            const float lb = LB[h * 128 + k];
            qs[e] = bf2f(row[C_HQ]) * 0.08838834764831845f;
            fs[e] = lb + (1.0f - lb) / (1.0f + __expf(-bf2f(row[C_HF])));
            is[e] = bf2f(row[C_HI]); }
        __syncthreads();
        for (int s = 0; s < 16; ++s) { const float vv = is[s * 128 + v]; float acc = 0.f;
#pragma unroll
            for (int i = 0; i < 32; ++i) { const float f = fs[s * 128 + kq * 32 + i], q = qs[s * 128 + kq * 32 + i]; S[i] = f * S[i] + (1.0f - f) * vv; acc += q * S[i]; }
            po[(s * 4 + kq) * 128 + v] = acc; }
        __syncthreads();
#pragma unroll
        for (int ss = 0; ss < 2; ++ss) { const int s = F.wave * 2 + ss; const int tok = b * SEQ + t0 + s;
            const float o0 = (po[(s * 4 + 0) * 128 + F.lane] + po[(s * 4 + 1) * 128 + F.lane]) + (po[(s * 4 + 2) * 128 + F.lane] + po[(s * 4 + 3) * 128 + F.lane]);
            const float o1 = (po[(s * 4 + 0) * 128 + 64 + F.lane] + po[(s * 4 + 1) * 128 + 64 + F.lane]) + (po[(s * 4 + 2) * 128 + 64 + F.lane] + po[(s * 4 + 3) * 128 + 64 + F.lane]);
            const float rstd = 1.0f / sqrtf(wave_sum(o0 * o0 + o1 * o1) * (1.f / 128.f) + EPS);
            const bf16* grow = PROJ + (size_t)tok * LDP + C_HG + h * 128;
            const float g0 = bf2f(grow[F.lane]), g1 = bf2f(grow[64 + F.lane]);
            Y[(size_t)tok * DM + h * 128 + F.lane] = (bf16)f2bf(o0 * rstd * gain[F.lane] * (g0 / (1.0f + __expf(-g0))));
            Y[(size_t)tok * DM + h * 128 + 64 + F.lane] = (bf16)f2bf(o1 * rstd * gain[64 + F.lane] * (g1 / (1.0f + __expf(-g1)))); }
        __syncthreads();
    }
}
__device__ __forceinline__ float dot64(const LAS float* q, const bf16* krow) {
    const v4u* kr = (const v4u*)krow; float s = 0.f;
#pragma unroll
    for (int j = 0; j < 8; ++j) { const v4u w = kr[j]; const LAS float* qq = q + 8 * j;
        s += qq[0] * bflo(w.x) + qq[1] * bfhi(w.x) + qq[2] * bflo(w.y) + qq[3] * bfhi(w.y) + qq[4] * bflo(w.z) + qq[5] * bfhi(w.z) + qq[6] * bflo(w.w) + qq[7] * bfhi(w.w); }
    return s;
}
__device__ __forceinline__ void n3_attn_item(Frame& F, int item, LAS float* scr) {
    const bf16* PROJ = (const bf16*)(F.ws + WS_PROJ);
    const bf16* KC = (const bf16*)(F.ws + WS_KC); const bf16* VC = (const bf16*)(F.ws + WS_VC);
    const float* COS = (const float*)(F.ws + SM_COS); const float* SIN = (const float*)(F.ws + SM_SIN);
    float* ONSA = (float*)(F.ws + WS_ONSA);
    const int lane = F.lane;
    const int g = item & 3, tok = item >> 2, b = tok >> 12, t = tok & (SEQ - 1), cur = t >> 6;
    LAS float* qf = scr; LAS float* qr = scr + 256; LAS float* ps = scr + 512; LAS float* pc = scr + 768; LAS float* pb = scr + 1024;
    const bf16* qrow = PROJ + (size_t)tok * LDP + C_NQ + g * 256;
#pragma unroll
    for (int r = 0; r < 4; ++r) { const float q = bf2f(qrow[r * 64 + lane]); qf[r * 64 + lane] = q;
        const float qp = bf2f(qrow[r * 64 + (lane ^ 32)]); const float c = COS[t * 32 + (lane & 31)], s = SIN[t * 32 + (lane & 31)];
        qr[r * 64 + lane] = (lane < 32) ? (q * c - qp * s) : (q * c + qp * s); }
#pragma unroll
    for (int i = 0; i < 4; ++i) ps[i * 64 + lane] = 0.f;
    LDS_WAIT();
    const int nvalid = (t >= 31) ? ((t - 31) >> 4) + 1 : 0;
    float oc[4];
#pragma unroll
    for (int r = 0; r < 4; ++r) {
        float s[4]; float m = -3.0e38f;
#pragma unroll
        for (int i = 0; i < 4; ++i) { const int c = lane + 64 * i; s[i] = (c < nvalid) ? dot64(qf + r * 64, KC + ((size_t)(b * 256 + c) * 4 + g) * 64) * 0.125f : -3.0e38f; m = fmaxf(m, s[i]); }
        m = wave_max(m); float e[4]; float sum = 0.f;
#pragma unroll
        for (int i = 0; i < 4; ++i) { const int c = lane + 64 * i; e[i] = (c < nvalid) ? __expf(s[i] - m) : 0.f; sum += e[i]; }
        sum = wave_sum(sum); const float inv = (nvalid > 0) ? 1.0f / sum : 0.f;
#pragma unroll
        for (int i = 0; i < 4; ++i) { const float p = e[i] * inv; pc[i * 64 + lane] = p; ps[i * 64 + lane] += p; }
        LDS_WAIT();
        float a = 0.f;
        for (int c = 0; c < nvalid; ++c) a += pc[c] * bf2f(VC[((size_t)(b * 256 + c) * 4 + g) * 64 + lane]);
        oc[r] = a;
        LDS_WAIT();
    }
    float imp = 0.f;
#pragma unroll
    for (int dc = -1; dc <= 3; ++dc) { const int c = 4 * lane + dc; if (c >= 0 && c <= 254) imp += ps[c]; }
    const bool forced = (lane == 0) || (lane == cur) || (lane == cur - 1);
    const bool causal = lane <= cur;
    const float val = forced ? 1.0e9f : (causal ? imp : -1.0e9f);
    int rank = 0;
    for (int i = 0; i < 64; ++i) { const float vi = __shfl(val, i); rank += (vi > val || (vi == val && i < lane)) ? 1 : 0; }
    const unsigned long long selmask = __ballot((rank < 16) && causal);
    const bf16* gr = PROJ + (size_t)tok * LDP + C_GR + g * 12;
#pragma unroll
    for (int r = 0; r < 4; ++r) {
        float m = -3.0e38f, l = 0.f, acc = 0.f;
        unsigned long long mk = selmask;
        while (mk) { const int jb = __builtin_ctzll(mk); mk &= mk - 1;
            const int pos = jb * 64 + lane; const bool valid = pos <= t;
            const float s = valid ? dot64(qr + r * 64, PROJ + (size_t)(b * SEQ + pos) * LDP + C_KS + g * 64) * 0.125f : -3.0e38f;
            const float mn = fmaxf(m, wave_max(s)); const float alpha = __expf(m - mn); const float p = valid ? __expf(s - mn) : 0.f;
            l = l * alpha + wave_sum(p); acc *= alpha; pb[lane] = p; LDS_WAIT();
            const bf16* vb = PROJ + (size_t)(b * SEQ + jb * 64) * LDP + C_VS + g * 64 + lane;
            for (int k = 0; k < 64; ++k) acc += pb[k] * bf2f(vb[(size_t)k * LDP]);
            m = mn; LDS_WAIT(); }
        const float os = acc / l;
        m = -3.0e38f; l = 0.f; acc = 0.f;
        for (int i = 0; i < 8; ++i) { const int base = t - 511 + 64 * i; if (base + 63 < 0) continue;
            const int pos = base + lane; const bool valid = pos >= 0;
            const float s = valid ? dot64(qr + r * 64, PROJ + (size_t)(b * SEQ + pos) * LDP + C_KW + g * 64) * 0.125f : -3.0e38f;
            const float mn = fmaxf(m, wave_max(s)); const float alpha = __expf(m - mn); const float p = valid ? __expf(s - mn) : 0.f;
            l = l * alpha + wave_sum(p); acc *= alpha; pb[lane] = p; LDS_WAIT();
            const int k0 = base < 0 ? -base : 0;
            const bf16* vb = PROJ + (size_t)(b * SEQ) * LDP + C_VW + g * 64 + lane;
            for (int k = k0; k < 64; ++k) acc += pb[k] * bf2f(vb[(size_t)(base + k) * LDP]);
            m = mn; LDS_WAIT(); }
        const float ow = acc / l;
        const float gc = 1.0f / (1.0f + __expf(-bf2f(gr[r * 3 + 0]))), gs = 1.0f / (1.0f + __expf(-bf2f(gr[r * 3 + 1]))), gw = 1.0f / (1.0f + __expf(-bf2f(gr[r * 3 + 2])));
        ONSA[(size_t)tok * 1024 + (g * 4 + r) * 64 + lane] = gc * oc[r] + gs * os + gw * ow;
    }
}
__device__ __forceinline__ void n3_mixers(Frame& F) {
#if NAIVE_HGRN
    if (F.vcu < 32) n3_hgrn(F, F.vcu);
#endif
    LAS float* scr = (LAS float*)(F.lds + RING_OFF + F.wave * 16384);
    const int gw = F.vcu * NWAVES + F.wave, NGW = F.G * NWAVES;
    for (int it = gw; it < NTOK * 4; it += NGW) n3_attn_item(F, it, scr);
}
constexpr int PH = 272;
constexpr int IMG_Q = 0, IMG_K = 64 * PH, IMG_KH = 2 * 64 * PH, IMG_V = 3 * 64 * PH, HG_SEG = 4 * 64 * PH;
__device__ __forceinline__ unsigned pkc(float a, float b) { typedef __bf16 bf2 __attribute__((ext_vector_type(2))); typedef float f2 __attribute__((ext_vector_type(2))); f2 v = {a, b}; bf2 r = __builtin_convertvector(v, bf2); return __builtin_bit_cast(unsigned, r); }
__device__ __forceinline__ bf16x8 pack8(const f32x16& x, int s) { v4u p;
    if (s == 0) { p.x = pkc(x[0], x[1]); p.y = pkc(x[2], x[3]); p.z = pkc(x[4], x[5]); p.w = pkc(x[6], x[7]); }
    else { p.x = pkc(x[8], x[9]); p.y = pkc(x[10], x[11]); p.z = pkc(x[12], x[13]); p.w = pkc(x[14], x[15]); }
    return __builtin_bit_cast(bf16x8, p); }
__device__ __forceinline__ f32x16 mfma32(bf16x8 a, bf16x8 b, f32x16 c) { return __builtin_amdgcn_mfma_f32_32x32x16_bf16(a, b, c, 0, 0, 0); }
__device__ __forceinline__ bf16x8 tr_frag(unsigned a0, unsigned a1) { s16x4 lo, hi;
    asm volatile("ds_read_b64_tr_b16 %0, %2\n\tds_read_b64_tr_b16 %1, %3\n\ts_waitcnt lgkmcnt(0)" : "=&v"(lo), "=&v"(hi) : "v"(a0), "v"(a1) : "memory");
    return __builtin_shufflevector(lo, hi, 0, 1, 2, 3, 4, 5, 6, 7); }
__device__ __forceinline__ f32x16 zero16() { f32x16 z;
#pragma unroll
    for (int i = 0; i < 16; ++i) z[i] = 0.f; return z; }

__device__ __forceinline__ void tr_read8(unsigned a0, unsigned a1, unsigned a2, unsigned a3, unsigned a4, unsigned a5, unsigned a6, unsigned a7, bf16x8& f0, bf16x8& f1, bf16x8& f2, bf16x8& f3) {
    s16x4 x0, x1, x2, x3, x4, x5, x6, x7;
    asm volatile("ds_read_b64_tr_b16 %0, %8\n\tds_read_b64_tr_b16 %1, %9\n\tds_read_b64_tr_b16 %2, %10\n\tds_read_b64_tr_b16 %3, %11\n\t"
                 "ds_read_b64_tr_b16 %4, %12\n\tds_read_b64_tr_b16 %5, %13\n\tds_read_b64_tr_b16 %6, %14\n\tds_read_b64_tr_b16 %7, %15\n\ts_waitcnt lgkmcnt(0)"
                 : "=&v"(x0), "=&v"(x1), "=&v"(x2), "=&v"(x3), "=&v"(x4), "=&v"(x5), "=&v"(x6), "=&v"(x7)
                 : "v"(a0), "v"(a1), "v"(a2), "v"(a3), "v"(a4), "v"(a5), "v"(a6), "v"(a7) : "memory");
    f0 = __builtin_shufflevector(x0, x1, 0, 1, 2, 3, 4, 5, 6, 7); f1 = __builtin_shufflevector(x2, x3, 0, 1, 2, 3, 4, 5, 6, 7);
    f2 = __builtin_shufflevector(x4, x5, 0, 1, 2, 3, 4, 5, 6, 7); f3 = __builtin_shufflevector(x6, x7, 0, 1, 2, 3, 4, 5, 6, 7);
}
template <bool STORE> __device__ __forceinline__ void hgrn_passA(Frame& F) {
    bf16* PROJ = (bf16*)(F.ws + WS_PROJ); bf16* OI = (bf16*)(F.ws + WS_OI); bf16* U = (bf16*)(F.ws + WS_U); float* DD = (float*)(F.ws + WS_DD);
    const float* LB = (const float*)(F.ws + SM_LB);
    LAS unsigned char* L = F.lds; const unsigned lbase = (unsigned)(size_t)L;
    const int lane = F.lane, r = lane & 31, h = lane >> 5;
    const unsigned trl = (unsigned)(((lane & 15) >> 2) * PH + (16 * ((lane >> 4) & 1) + 4 * (lane & 3)) * 2);
    const int k = F.tid & 127, seg = F.tid >> 7;
    LAS int* qslot = (LAS int*)(L + HG_SEG + 2048);
    gu32* qctr = F.ctl + (STORE ? CW_HQ : CW_HQ + 1);
    if (F.tid == 0) *qslot = (int)__hip_atomic_fetch_add(qctr, 1u, RLX_AGENT);
    __syncthreads();
    int unit = *qslot;
    __syncthreads();
    unsigned short fw[16], qw[16], iw[16];
    if (unit < 2048) { const bf16* cp0 = PROJ + (size_t)((unit >> 9) * SEQ + (unit & 63) * 64 + seg * 16) * LDP + ((unit >> 6) & 7) * 128 + k;
#pragma unroll
        for (int i = 0; i < 16; ++i) { fw[i] = cp0[(size_t)i * LDP + C_HF]; qw[i] = cp0[(size_t)i * LDP + C_HQ]; iw[i] = cp0[(size_t)i * LDP + C_HI]; } }
    while (unit < 2048) {
        const int hh = (unit >> 6) & 7, c = unit & 63, tok0 = (unit >> 9) * SEQ + c * 64;
        if (F.tid == 0) *qslot = (int)__hip_atomic_fetch_add(qctr, 1u, RLX_AGENT);
        const float lb = LB[hh * 128 + k];
        float cs[16], kf[16]; float run = 0.f;
        bf16* colp = PROJ + (size_t)(tok0 + seg * 16) * LDP + hh * 128 + k;
#pragma unroll
        for (int i = 0; i < 16; ++i) { const float fr = bf2f(fw[i]); const float f = lb + (1.0f - lb) / (1.0f + __expf(-fr)); run += __logf(f); cs[i] = run; kf[i] = 1.0f - f; }
        LAS float* segtot = (LAS float*)(L + HG_SEG);
        segtot[seg * 128 + k] = run;
        __syncthreads();
        const int next = *qslot;
        const float t0 = segtot[k], t1 = segtot[128 + k], t2 = segtot[256 + k], t3 = segtot[384 + k];
        const float off = (seg > 0 ? t0 : 0.f) + (seg > 1 ? t1 : 0.f) + (seg > 2 ? t2 : 0.f);
        const float bmid = t0 + t1, tot = (t0 + t1) + (t2 + t3);
        const float E3 = __expf(tot - bmid), E4 = __expf(bmid);
#pragma unroll
        for (int i = 0; i < 16; ++i) { const int t = seg * 16 + i; const float bc = off + cs[i];
            const float qv = bf2f(qw[i]) * 0.08838834764831845f;
            const float e1 = __expf(fminf(fmaxf(bc - bmid, -80.f), 80.f)), e2 = __builtin_amdgcn_rcpf(e1);
            const float qt = qv * e1, kt = kf[i] * e2;
            *(LAS bf16*)(L + IMG_Q + t * PH + k * 2) = (bf16)f2bf(qt);
            *(LAS bf16*)(L + IMG_K + t * PH + k * 2) = (bf16)f2bf(kt);
            *(LAS bf16*)(L + IMG_KH + t * PH + k * 2) = (bf16)f2bf(kt * E3);
            *(LAS bf16*)(L + IMG_V + t * PH + k * 2) = iw[i];
            if (STORE) colp[(size_t)i * LDP + C_HQ] = (bf16)f2bf(qt * E4); }
        if (STORE && seg == 0) DD[unit * 128 + k] = __expf(tot);
        __syncthreads();
        if (next < 2048) { const bf16* cp0 = PROJ + (size_t)((next >> 9) * SEQ + (next & 63) * 64 + seg * 16) * LDP + ((next >> 6) & 7) * 128 + k;
#pragma unroll
            for (int i = 0; i < 16; ++i) { fw[i] = cp0[(size_t)i * LDP + C_HF]; qw[i] = cp0[(size_t)i * LDP + C_HQ]; iw[i] = cp0[(size_t)i * LDP + C_HI]; } }
        const int tg = F.wave & 1, vt = F.wave >> 1;
        f32x16 oacc = zero16();
#pragma unroll
        for (int mt = 0; mt < 2; ++mt) {
            if (mt <= tg) {
                f32x16 s = zero16();
#pragma unroll
                for (int ks = 0; ks < 8; ++ks) { const bf16x8 a = *(const LAS bf16x8*)(L + IMG_K + (32 * mt + r) * PH + (16 * ks + 8 * h) * 2); const bf16x8 b = *(const LAS bf16x8*)(L + IMG_Q + (32 * tg + r) * PH + (16 * ks + 8 * h) * 2); s = mfma32(a, b, s); }
                if (mt == tg) {
#pragma unroll
                    for (int i = 0; i < 16; ++i) { const int sr = (i & 3) + 8 * (i >> 2) + 4 * h; if (sr > r) s[i] = 0.f; } }
                const unsigned a0 = lbase + IMG_V + (32 * mt + 4 * h) * PH + (32 * vt) * 2 + trl;
                const bf16x8 af0 = tr_frag(a0, a0 + 8 * PH), af1 = tr_frag(a0 + 16 * PH, a0 + 24 * PH);
                oacc = mfma32(af0, pack8(s, 0), oacc); oacc = mfma32(af1, pack8(s, 1), oacc);
            }
        }
        if (STORE) {   bf16* orow = OI + (size_t)(tok0 + 32 * tg + r) * 1024 + hh * 128 + 32 * vt + 4 * h;
#pragma unroll
            for (int g = 0; g < 4; ++g) { v2u w; w.x = pkc(oacc[4 * g], oacc[4 * g + 1]); w.y = pkc(oacc[4 * g + 2], oacc[4 * g + 3]); *(v2u*)(orow + 8 * g) = w; } }
        {   bf16x8 bv0, bv1, bv2, bv3; const unsigned rb = lbase + IMG_V + (8 * h) * PH + (32 * vt) * 2 + trl;
            tr_read8(rb, rb + 4 * PH, rb + 16 * PH, rb + 20 * PH, rb + 32 * PH, rb + 36 * PH, rb + 48 * PH, rb + 52 * PH, bv0, bv1, bv2, bv3);
#pragma unroll
            for (int kk2 = 0; kk2 < 2; ++kk2) { const int kt = 2 * (F.wave & 1) + kk2;
                bf16x8 av0, av1, av2, av3; const unsigned ra = lbase + IMG_KH + (8 * h) * PH + (32 * kt) * 2 + trl;
                tr_read8(ra, ra + 4 * PH, ra + 16 * PH, ra + 20 * PH, ra + 32 * PH, ra + 36 * PH, ra + 48 * PH, ra + 52 * PH, av0, av1, av2, av3);
                f32x16 u = zero16(); u = mfma32(av0, bv0, u); u = mfma32(av1, bv1, u); u = mfma32(av2, bv2, u); u = mfma32(av3, bv3, u);
                if (STORE) { bf16* up = U + (size_t)unit * 16384 + 32 * vt + r;
#pragma unroll
                    for (int i = 0; i < 16; ++i) { const int kr = 32 * kt + (i & 3) + 8 * (i >> 2) + 4 * h; up[kr * 128] = (bf16)f2bf(u[i]); } } } }
        __syncthreads();
        unit = next;
    }
}
__device__ __forceinline__ void hgrn_scan(Frame& F) {
    const bf16* U = (const bf16*)(F.ws + WS_U); bf16* SPo = (bf16*)(F.ws + WS_SP); const float* DD = (const float*)(F.ws + WS_DD);
    for (int idx = F.vcu * 512 + F.tid; idx < 32 * 4096; idx += F.G * 512) {
        const int bh = idx >> 12, e0 = (idx & 4095) * 4, k = e0 >> 7;
        float S0 = 0.f, S1 = 0.f, S2 = 0.f, S3 = 0.f;
        for (int c0 = 0; c0 < 64; c0 += 8) {
            v2u u[8]; float dv[8];
#pragma unroll
            for (int i = 0; i < 8; ++i) { const int unit = bh * 64 + c0 + i; u[i] = *(const v2u*)(U + (size_t)unit * 16384 + e0); dv[i] = DD[unit * 128 + k]; }
#pragma unroll
            for (int i = 0; i < 8; ++i) { const int unit = bh * 64 + c0 + i;
                v2u o; o.x = pkc(S0, S1); o.y = pkc(S2, S3);
                *(v2u*)(SPo + (size_t)unit * 16384 + e0) = o;
                S0 = dv[i] * S0 + bflo(u[i].x); S1 = dv[i] * S1 + bfhi(u[i].x); S2 = dv[i] * S2 + bflo(u[i].y); S3 = dv[i] * S3 + bfhi(u[i].y); }
        }
    }
}
__device__ __forceinline__ void hgrn_passB(Frame& F) {
    const bf16* PROJ = (const bf16*)(F.ws + WS_PROJ); const bf16* OI = (const bf16*)(F.ws + WS_OI); const bf16* SP = (const bf16*)(F.ws + WS_SP); bf16* Y = (bf16*)(F.ws + WS_B);
    const float* gain = F.in[IN_HG_NORM];
    LAS unsigned char* L = F.lds; const unsigned lbase = (unsigned)(size_t)L;
    LAS float* ss = (LAS float*)(L + 128 * PH);
    const int lane = F.lane, r = lane & 31, h = lane >> 5;
    const unsigned trl = (unsigned)(((lane & 15) >> 2) * PH + (16 * ((lane >> 4) & 1) + 4 * (lane & 3)) * 2);
    v4u spre[4];
    if (F.vcu < 2048) {
#pragma unroll
        for (int i = 0; i < 4; ++i) spre[i] = *(const v4u*)(SP + (size_t)F.vcu * 16384 + (i * 512 + F.tid) * 8); }
    for (int unit = F.vcu; unit < 2048; unit += F.G) {
        const int hh = (unit >> 6) & 7, c = unit & 63, tok0 = (unit >> 9) * SEQ + c * 64;
        const int tg = F.wave & 1, vt = F.wave >> 1;
        bf16x8 qb_[8];
        {   const bf16* qrow = PROJ + (size_t)(tok0 + 32 * tg + r) * LDP + C_HQ + hh * 128 + 8 * h;
#pragma unroll
            for (int ks = 0; ks < 8; ++ks) qb_[ks] = *(const bf16x8*)(qrow + 16 * ks); }
#pragma unroll
        for (int i = 0; i < 4; ++i) { const int e = (i * 512 + F.tid) * 8, kr = e >> 7, vc = e & 127; *(LAS v4u*)(L + kr * PH + vc * 2) = spre[i]; }
        __syncthreads();
        if (unit + F.G < 2048) {
#pragma unroll
            for (int i = 0; i < 4; ++i) spre[i] = *(const v4u*)(SP + (size_t)(unit + F.G) * 16384 + (i * 512 + F.tid) * 8); }
        f32x16 acc = zero16();
        if (c > 0) {
#pragma unroll
            for (int kq = 0; kq < 2; ++kq) { const unsigned ra = lbase + (64 * kq + 8 * h) * PH + (32 * vt) * 2 + trl; bf16x8 a0, a1, a2, a3;
                tr_read8(ra, ra + 4 * PH, ra + 16 * PH, ra + 20 * PH, ra + 32 * PH, ra + 36 * PH, ra + 48 * PH, ra + 52 * PH, a0, a1, a2, a3);
                acc = mfma32(a0, qb_[4 * kq], acc); acc = mfma32(a1, qb_[4 * kq + 1], acc); acc = mfma32(a2, qb_[4 * kq + 2], acc); acc = mfma32(a3, qb_[4 * kq + 3], acc); }
        }
        const int tok = tok0 + 32 * tg + r; const int vb = hh * 128 + 32 * vt + 4 * h;
        float sq = 0.f;
#pragma unroll
        for (int g = 0; g < 4; ++g) { const v2u w = *(const v2u*)(OI + (size_t)tok * 1024 + vb + 8 * g);
            acc[4 * g] += bflo(w.x); acc[4 * g + 1] += bfhi(w.x); acc[4 * g + 2] += bflo(w.y); acc[4 * g + 3] += bfhi(w.y);
            sq += (acc[4 * g] * acc[4 * g] + acc[4 * g + 1] * acc[4 * g + 1]) + (acc[4 * g + 2] * acc[4 * g + 2] + acc[4 * g + 3] * acc[4 * g + 3]); }
        sq += __shfl_xor(sq, 32);
        if (h == 0) ss[vt * 64 + 32 * tg + r] = sq;
        __syncthreads();
        const int tl = 32 * tg + r;
        const float rstd = 1.0f / sqrtf(((ss[tl] + ss[64 + tl]) + (ss[128 + tl] + ss[192 + tl])) * (1.f / 128.f) + EPS);
#pragma unroll
        for (int g = 0; g < 4; ++g) { const int vl = 32 * vt + 4 * h + 8 * g; const f32x4 gn = *(const f32x4*)(gain + vl);
            const v2u gw = *(const v2u*)(PROJ + (size_t)tok * LDP + C_HG + hh * 128 + vl);
            const float g0 = bflo(gw.x), g1 = bfhi(gw.x), g2 = bflo(gw.y), g3 = bfhi(gw.y);
            v2u w; w.x = pkc(acc[4 * g] * rstd * gn.x * (g0 / (1.0f + __expf(-g0))), acc[4 * g + 1] * rstd * gn.y * (g1 / (1.0f + __expf(-g1))));
            w.y = pkc(acc[4 * g + 2] * rstd * gn.z * (g2 / (1.0f + __expf(-g2))), acc[4 * g + 3] * rstd * gn.w * (g3 / (1.0f + __expf(-g3))));
            *(v2u*)(Y + (size_t)tok * DM + hh * 128 + vl) = w; }
        __syncthreads();
    }
}
constexpr int KP = 144;
constexpr int C_MSK_ = 256 * 144 + 256 * 272 + 16384;
constexpr int RB = 8192;
constexpr int A_K = 0, A_V = 6 * RB, A_VX = 12 * RB, A_CK = A_VX + 64 * PH, A_MSK = C_MSK_, A_IMP = A_V;
constexpr int C_KI = 0, C_VX = 256 * KP, C_IMP = C_VX + 256 * PH, C_MSK = C_IMP + 16384;
static_assert(C_MSK + 2048 <= RING_BYTES && C_MSK >= A_VX, "attention LDS map");
constexpr float QSCALE = 0.125f * 1.4426950408889634f;
constexpr float NEGBIG = -1.0e30f;

__device__ __forceinline__ void tr_frag4(unsigned a, int pitch8, int dstep, bf16x8& f00, bf16x8& f01, bf16x8& f10, bf16x8& f11) {
    s16x4 l0, h0, l1, h1, l2, h2, l3, h3;
    const unsigned b0 = a, b1 = a + dstep, b2 = a + 2 * pitch8, b3 = a + 2 * pitch8 + dstep;
    asm volatile("ds_read_b64_tr_b16 %0, %8\n\tds_read_b64_tr_b16 %1, %9\n\tds_read_b64_tr_b16 %2, %10\n\tds_read_b64_tr_b16 %3, %11\n\t"
                 "ds_read_b64_tr_b16 %4, %12\n\tds_read_b64_tr_b16 %5, %13\n\tds_read_b64_tr_b16 %6, %14\n\tds_read_b64_tr_b16 %7, %15\n\ts_waitcnt lgkmcnt(0)"
                 : "=&v"(l0), "=&v"(h0), "=&v"(l1), "=&v"(h1), "=&v"(l2), "=&v"(h2), "=&v"(l3), "=&v"(h3)
                 : "v"(b0), "v"(b0 + pitch8), "v"(b1), "v"(b1 + pitch8), "v"(b2), "v"(b2 + pitch8), "v"(b3), "v"(b3 + pitch8) : "memory");
    f00 = __builtin_shufflevector(l0, h0, 0, 1, 2, 3, 4, 5, 6, 7); f01 = __builtin_shufflevector(l1, h1, 0, 1, 2, 3, 4, 5, 6, 7);
    f10 = __builtin_shufflevector(l2, h2, 0, 1, 2, 3, 4, 5, 6, 7); f11 = __builtin_shufflevector(l3, h3, 0, 1, 2, 3, 4, 5, 6, 7);
}
__device__ __forceinline__ void qk_tile(const LAS unsigned char* Kimg, const bf16x8 (&qf)[4], f32x16& s0, f32x16& s1, int r, int h) {
    s0 = zero16(); s1 = zero16();
#pragma unroll
    for (int ks = 0; ks < 4; ++ks) { const bf16x8 a0 = *(const LAS bf16x8*)(Kimg + r * KP + (16 * ks + 8 * h) * 2), a1 = *(const LAS bf16x8*)(Kimg + (32 + r) * KP + (16 * ks + 8 * h) * 2);
        s0 = mfma32(a0, qf[ks], s0); s1 = mfma32(a1, qf[ks], s1); }
}
template <int MODE> __device__ __forceinline__ void mask_tile(f32x16& s0, f32x16& s1, int tl, int h, bool sel) {
#pragma unroll
    for (int i = 0; i < 16; ++i) { const int k0 = (i & 3) + 8 * (i >> 2) + 4 * h, k1 = k0 + 32;
        bool v0 = sel, v1 = sel;
        if (MODE == 1) { v0 = v0 && (k0 <= tl); v1 = v1 && (k1 <= tl); }
        if (MODE == 2) { v0 = v0 && (k0 > tl); v1 = v1 && (k1 > tl); }
        s0[i] = v0 ? s0[i] : NEGBIG; s1[i] = v1 ? s1[i] : NEGBIG; }
}
template <int MODE, bool TWO = false> __device__ __forceinline__ void softmax_tile(f32x16& s0, f32x16& s1, float& m, float& l, f32x16& o0, f32x16& o1, int tl, int h, bool sel, int klo_ = 0, int khi_ = 63, f32x16* e0 = nullptr, f32x16* e1 = nullptr) {
    if (MODE != 0) {
        const int tlh = tl - 4 * h, loh = klo_ - 4 * h, hih = khi_ - 4 * h;
#pragma unroll
        for (int i = 0; i < 16; ++i) { const int c0 = (i & 3) + 8 * (i >> 2), c1 = c0 + 32;
            const bool v0 = (MODE == 1) ? (c0 <= tlh) : (MODE == 2) ? (c0 > tlh) : (c0 >= loh && c0 <= hih), v1 = (MODE == 1) ? (c1 <= tlh) : (MODE == 2) ? (c1 > tlh) : (c1 >= loh && c1 <= hih);
            s0[i] = v0 ? s0[i] : NEGBIG; s1[i] = v1 ? s1[i] : NEGBIG; } }
    float mx = fmaxf(s0[0], s1[0]);
#pragma unroll
    for (int i = 1; i < 16; ++i) mx = fmaxf(mx, fmaxf(s0[i], s1[i]));
    mx = fmaxf(mx, __shfl_xor(mx, 32));
    const float mn = sel ? fmaxf(m, mx) : m;
    if (__ballot(mn > m) != 0ull) { const float alpha = __builtin_amdgcn_exp2f(m - mn); l *= alpha;
#pragma unroll
        for (int i = 0; i < 16; ++i) { o0[i] *= alpha; o1[i] *= alpha; }
        if (TWO) {
#pragma unroll
            for (int i = 0; i < 16; ++i) { (*e0)[i] *= alpha; (*e1)[i] *= alpha; } } }
    m = mn;
    const float me = sel ? mn : 1.0e30f; float sum = 0.f;
#pragma unroll
    for (int i = 0; i < 16; ++i) { s0[i] = __builtin_amdgcn_exp2f(s0[i] - me); s1[i] = __builtin_amdgcn_exp2f(s1[i] - me); sum += s0[i] + s1[i]; }
    l += sum;
}
__device__ __forceinline__ void pv_tile(unsigned vaddr, const f32x16& p0, const f32x16& p1, f32x16& o0, f32x16& o1, int h, unsigned trl) {
    bf16x8 f00, f01, f10, f11;
    tr_frag4(vaddr + (4 * h) * KP + trl, 8 * KP, 64, f00, f01, f10, f11);
    { const bf16x8 pa = pack8(p0, 0), pb = pack8(p0, 1); o0 = mfma32(f00, pa, o0); o1 = mfma32(f01, pa, o1); o0 = mfma32(f10, pb, o0); o1 = mfma32(f11, pb, o1); }
    tr_frag4(vaddr + (32 + 4 * h) * KP + trl, 8 * KP, 64, f00, f01, f10, f11);
    { const bf16x8 pa = pack8(p1, 0), pb = pack8(p1, 1); o0 = mfma32(f00, pa, o0); o1 = mfma32(f01, pa, o1); o0 = mfma32(f10, pb, o0); o1 = mfma32(f11, pb, o1); }
}

template <int VAR> __device__ __forceinline__ void attn_cmp_unit(Frame& F, int b, int g, int qb, int uidx) {
    const bf16* PROJ = (const bf16*)(F.ws + WS_PROJ); float* ONSA = (float*)(F.ws + (VAR ? WS_B : WS_ONSA));
    LAS unsigned char* L = F.lds; const unsigned lbase = (unsigned)(size_t)L;
    const int lane = F.lane, r = lane & 31, h = lane >> 5, w = F.wave;
    const int tl = 8 * w + (r >> 2), t = 64 * qb + tl, tok = b * SEQ + t, head = g * 4 + (r & 3);
    const unsigned trlX = (unsigned)(((lane & 15) >> 2) * PH + (16 * ((lane >> 4) & 1) + 4 * (lane & 3)) * 2);
    const bf16* qp = PROJ + (size_t)tok * LDP + C_NQ + head * 64 + 8 * h;
    bf16x8 qraw[4];
#pragma unroll
    for (int ks = 0; ks < 4; ++ks) { const v4u wv = *(const v4u*)(qp + 16 * ks); v4u p;
        p.x = pkc(bflo(wv.x) * QSCALE, bfhi(wv.x) * QSCALE); p.y = pkc(bflo(wv.y) * QSCALE, bfhi(wv.y) * QSCALE); p.z = pkc(bflo(wv.z) * QSCALE, bfhi(wv.z) * QSCALE); p.w = pkc(bflo(wv.w) * QSCALE, bfhi(wv.w) * QSCALE);
        qraw[ks] = __builtin_bit_cast(bf16x8, p); }
    const int nct = (4 * qb + 3 + 63) >> 6;
    const int nv = (t >= 31) ? ((t - 31) >> 4) + 1 : 0;
    float m = NEGBIG, l = 0.f;
    f32x16 im0 = zero16(), im1 = zero16();
    {   f32x16 o0 = zero16(), o1 = zero16();
#pragma unroll 1
        for (int ct = 0; ct < nct; ++ct) { const int hi_ = nv - 64 * ct - 1; const bool sel = hi_ >= 0;
            if (__ballot(sel) != 0ull) {
                f32x16 s0, s1; qk_tile(L + C_KI + 64 * ct * KP, qraw, s0, s1, r, h);
                softmax_tile<3, true>(s0, s1, m, l, o0, o1, tl, h, sel, 0, hi_, &im0, &im1);
                bf16x8 f00, f01, f10, f11; const unsigned va = lbase + C_VX + (64 * ct + 4 * h) * PH + trlX;
                { const bf16x8 pa = pack8(s0, 0), pb = pack8(s0, 1);
                  tr_frag4(va, 8 * PH, 64, f00, f01, f10, f11); o0 = mfma32(f00, pa, o0); o1 = mfma32(f01, pa, o1); o0 = mfma32(f10, pb, o0); o1 = mfma32(f11, pb, o1);
                  tr_frag4(va + 128, 8 * PH, 64, f00, f01, f10, f11); im0 = mfma32(f00, pa, im0); im1 = mfma32(f01, pa, im1); im0 = mfma32(f10, pb, im0); im1 = mfma32(f11, pb, im1); }
                { const bf16x8 pa = pack8(s1, 0), pb = pack8(s1, 1);
                  tr_frag4(va + 32 * PH, 8 * PH, 64, f00, f01, f10, f11); o0 = mfma32(f00, pa, o0); o1 = mfma32(f01, pa, o1); o0 = mfma32(f10, pb, o0); o1 = mfma32(f11, pb, o1);
                  tr_frag4(va + 32 * PH + 128, 8 * PH, 64, f00, f01, f10, f11); im0 = mfma32(f00, pa, im0); im1 = mfma32(f01, pa, im1); im0 = mfma32(f10, pb, im0); im1 = mfma32(f11, pb, im1); } } }
        const float lt = l + __shfl_xor(l, 32);
        l = (lt > 0.f) ? 1.0f / lt : 0.f;
        const float gc = l / (1.0f + __expf(-bf2f(PROJ[(size_t)tok * LDP + C_GR + head * 3])));
        float* op = ONSA + (size_t)tok * 1024 + head * 64 + 4 * h;
#pragma unroll
        for (int gq = 0; gq < 4; ++gq) { *(f32x4*)(op + 8 * gq) = (f32x4){gc * o0[4 * gq], gc * o0[4 * gq + 1], gc * o0[4 * gq + 2], gc * o0[4 * gq + 3]}; *(f32x4*)(op + 32 + 8 * gq) = (f32x4){gc * o1[4 * gq], gc * o1[4 * gq + 1], gc * o1[4 * gq + 2], gc * o1[4 * gq + 3]}; }
    }
#pragma unroll
    for (int i = 0; i < 16; ++i) { im0[i] *= l; im1[i] *= l; }
#pragma unroll
    for (int i = 0; i < 16; ++i) { im0[i] += __shfl_xor(im0[i], 1); im0[i] += __shfl_xor(im0[i], 2); im1[i] += __shfl_xor(im1[i], 1); im1[i] += __shfl_xor(im1[i], 2); }
    LAS float* IMP = (LAS float*)(L + C_IMP);
    if ((r & 3) == 0) {
#pragma unroll
        for (int gq = 0; gq < 4; ++gq) { *(LAS f32x4*)(IMP + tl * 64 + 8 * gq + 4 * h) = (f32x4){im0[4 * gq], im0[4 * gq + 1], im0[4 * gq + 2], im0[4 * gq + 3]};
            *(LAS f32x4*)(IMP + tl * 64 + 32 + 8 * gq + 4 * h) = (f32x4){im1[4 * gq], im1[4 * gq + 1], im1[4 * gq + 2], im1[4 * gq + 3]}; }
    }
    LDS_WAIT();
#pragma unroll 1
    for (int ti = 0; ti < 8; ++ti) {
        const bool forced = (lane == 0) || (lane == qb) || (lane == qb - 1), causal = lane <= qb;
        const unsigned vb = __builtin_bit_cast(unsigned, IMP[(8 * w + ti) * 64 + lane]);
        const unsigned key = causal ? (((forced ? 0xFFFFFFC0u : (vb & ~63u))) | (unsigned)(63 - lane)) : 0u;
        unsigned T = 0u;
#pragma unroll 1
        for (int bit = 31; bit >= 0; --bit) { const unsigned cand = T | (1u << bit); if (__builtin_popcountll(__ballot(key >= cand)) >= 16) T = cand; }
        const unsigned long long mk = __ballot(causal && key >= T);
        if (lane == ti) ((LAS unsigned long long*)(L + C_MSK))[uidx * 64 + 8 * w + ti] = mk; }
    LDS_WAIT();
}

template <int VAR> __device__ __forceinline__ void attn_stream_unit(Frame& F, int b, int g, int qb, int uidx) {
    const bf16* PROJ = (const bf16*)(F.ws + WS_PROJ); const bf16* KC = (const bf16*)(F.ws + WS_KC); const bf16* VC = (const bf16*)(F.ws + WS_VC);
    const float* COS = (const float*)(F.ws + SM_COS); const float* SIN = (const float*)(F.ws + SM_SIN); float* ONSA = (float*)(F.ws + (VAR ? WS_B : WS_ONSA));
    LAS unsigned char* L = F.lds; const unsigned lbase = (unsigned)(size_t)L;
    const int lane = F.lane, r = lane & 31, h = lane >> 5, w = F.wave;
    const int tl = 8 * w + (r >> 2), t = 64 * qb + tl, tok = b * SEQ + t, head = g * 4 + (r & 3);
    const unsigned trlK = (unsigned)(((lane & 15) >> 2) * KP + (16 * ((lane >> 4) & 1) + 4 * (lane & 3)) * 2);
    const unsigned trlX = (unsigned)(((lane & 15) >> 2) * PH + (16 * ((lane >> 4) & 1) + 4 * (lane & 3)) * 2);
    const int srow = F.tid >> 3, spc = F.tid & 7;
    const bf16* qp = PROJ + (size_t)tok * LDP + C_NQ + head * 64 + 8 * h;
    const unsigned long long mymask = ((const LAS unsigned long long*)(L + C_MSK))[uidx * 64 + tl];
    bf16x8 qrot[4];
    {   float qa[4][8];
#pragma unroll
        for (int ks = 0; ks < 4; ++ks) { const v4u wv = *(const v4u*)(qp + 16 * ks);
            qa[ks][0] = bflo(wv.x); qa[ks][1] = bfhi(wv.x); qa[ks][2] = bflo(wv.y); qa[ks][3] = bfhi(wv.y); qa[ks][4] = bflo(wv.z); qa[ks][5] = bfhi(wv.z); qa[ks][6] = bflo(wv.w); qa[ks][7] = bfhi(wv.w); }
#pragma unroll
        for (int k2 = 0; k2 < 2; ++k2) { const float* cp = COS + t * 32 + 16 * k2 + 8 * h; const float* sp = SIN + t * 32 + 16 * k2 + 8 * h;
            const f32x4 c0 = *(const f32x4*)cp, c1 = *(const f32x4*)(cp + 4), s0 = *(const f32x4*)sp, s1 = *(const f32x4*)(sp + 4);
            float lo[8], hi[8];
#pragma unroll
            for (int j = 0; j < 8; ++j) { const float c = j < 4 ? c0[j & 3] : c1[j & 3], s = j < 4 ? s0[j & 3] : s1[j & 3]; lo[j] = (qa[k2][j] * c - qa[k2 + 2][j] * s) * QSCALE; hi[j] = (qa[k2 + 2][j] * c + qa[k2][j] * s) * QSCALE; }
            v4u p; p.x = pkc(lo[0], lo[1]); p.y = pkc(lo[2], lo[3]); p.z = pkc(lo[4], lo[5]); p.w = pkc(lo[6], lo[7]); qrot[k2] = __builtin_bit_cast(bf16x8, p);
            p.x = pkc(hi[0], hi[1]); p.y = pkc(hi[2], hi[3]); p.z = pkc(hi[4], hi[5]); p.w = pkc(hi[6], hi[7]); qrot[k2 + 2] = __builtin_bit_cast(bf16x8, p); }
    }
#if ATT_PARTS & 6
    {
        const int wv = F.wave, rr = (lane >> 2) & 7, chd = ((lane >> 5) << 2) | ((lane & 3) ^ (((wv & 1) << 1) | (rr >> 2)));
        const unsigned dsrc = (unsigned)(((b * SEQ + 8 * wv + rr) * LDP + g * 64 + chd * 8) * 2);
        const char* pbase = (const char*)PROJ;
        const int sK = (r >> 2) & 3; const unsigned rbK = (unsigned)(1024 * (r >> 3) + 64 * (r & 7));
        const unsigned aK0 = rbK + 16 * ((0 + h) ^ sK), aK1 = rbK + 16 * ((2 + h) ^ sK);
        const int q4 = (lane & 15) >> 2, p4 = lane & 3, blk = (lane >> 4) & 1;
        const unsigned lbV0 = (unsigned)(64 * (4 * h + q4) + 16 * ((2 * blk + (p4 >> 1)) ^ ((0 + h) & 3)) + 8 * (p4 & 1)), lbV1 = (unsigned)(64 * (4 * h + q4) + 16 * ((2 * blk + (p4 >> 1)) ^ ((2 + h) & 3)) + 8 * (p4 & 1));
#pragma unroll 1
        for (int br = 0; br < 2; ++br) {
            const int n = br ? ((qb < 8 ? qb : 8) + 1) : (qb + 1);
            const unsigned kcolb = (unsigned)((br ? C_KW : C_KS) * 2), vcolb = (unsigned)((br ? C_VW : C_VS) * 2);
#define TILE_OF(i) (br ? (qb - (i)) : (i))
#define DMA_TILE(i, buf) do { const char* tb_ = pbase + (size_t)(TILE_OF(i) * 64 * LDP * 2) + dsrc; \
                __builtin_amdgcn_global_load_lds((const unsigned*)(tb_ + kcolb), (LAS unsigned*)(L + A_K + (buf) * RB + 1024 * wv), 16, 0, 0); \
                __builtin_amdgcn_global_load_lds((const unsigned*)(tb_ + vcolb), (LAS unsigned*)(L + A_V + (buf) * RB + 1024 * wv), 16, 0, 0); } while (0)
            float m = NEGBIG, l = 0.f; f32x16 o0 = zero16(), o1 = zero16();
            const int np = (n + 1) >> 1;
            DMA_TILE(0, 0); if (n > 1) DMA_TILE(1, 1); if (n > 2) DMA_TILE(2, 2); if (n > 3) DMA_TILE(3, 3);
#pragma unroll 1
            for (int p = 0; p < np; ++p) {
                const int rem = n - 2 * (p + 1);
                if (rem >= 2) asm volatile("s_waitcnt vmcnt(4)" ::: "memory"); else if (rem == 1) asm volatile("s_waitcnt vmcnt(2)" ::: "memory"); else asm volatile("s_waitcnt vmcnt(0)" ::: "memory");
                __builtin_amdgcn_s_barrier(); asm volatile("" ::: "memory");
                { const int t4 = 2 * p + 4, sb = (p + 2) % 3 * 2; if (t4 < n) DMA_TILE(t4, sb); if (t4 + 1 < n) DMA_TILE(t4 + 1, sb + 1); }
#pragma unroll 1
                for (int i = 2 * p; i < 2 * p + 2 && i < n; ++i) { const int cb = (p % 3) * 2 + (i & 1);
                const bool sel = br ? true : (bool)((mymask >> i) & 1ull);
                if (__ballot(sel) != 0ull) {
                    const LAS unsigned char* Kb = L + A_K + cb * RB;
                    f32x16 sc0, sc1;
#define QK_TILE() do { sc0 = zero16(); sc1 = zero16(); \
                        const bf16x8 a00 = *(const LAS bf16x8*)(Kb + aK0), a01 = *(const LAS bf16x8*)(Kb + aK1), a02 = *(const LAS bf16x8*)(Kb + aK0 + 512), a03 = *(const LAS bf16x8*)(Kb + aK1 + 512); \
                        const bf16x8 a10 = *(const LAS bf16x8*)(Kb + 4096 + aK0), a11 = *(const LAS bf16x8*)(Kb + 4096 + aK1), a12 = *(const LAS bf16x8*)(Kb + 4096 + aK0 + 512), a13 = *(const LAS bf16x8*)(Kb + 4096 + aK1 + 512); \
                        sc0 = mfma32(a00, qrot[0], sc0); sc1 = mfma32(a10, qrot[0], sc1); sc0 = mfma32(a01, qrot[1], sc0); sc1 = mfma32(a11, qrot[1], sc1); \
                        sc0 = mfma32(a02, qrot[2], sc0); sc1 = mfma32(a12, qrot[2], sc1); sc0 = mfma32(a03, qrot[3], sc0); sc1 = mfma32(a13, qrot[3], sc1); } while (0)
                    int lo_ = 0, hi_ = 63;
                    if (br == 0) { if (i == qb) hi_ = tl; } else { if (i == 0) hi_ = tl; if (i == 8) lo_ = tl + 1; }
                    const bool edge = !(lo_ == 0 && hi_ == 63);
#pragma unroll 1
                    for (int attempt = 0; attempt < 3; ++attempt) {
                        QK_TILE();
                        if (VAR == 6) { l += 1.0f; break; }
                        if (edge) {
                            const int loh = lo_ - 4 * h, hih = hi_ - 4 * h;
#pragma unroll
                            for (int e = 0; e < 16; ++e) { const int c0 = (e & 3) + 8 * (e >> 2), c1 = c0 + 32; sc0[e] = (c0 >= loh && c0 <= hih) ? sc0[e] : NEGBIG; sc1[e] = (c1 >= loh && c1 <= hih) ? sc1[e] : NEGBIG; } }
                        if (attempt == 1) {
                            float mx = fmaxf(sc0[0], sc1[0]);
#pragma unroll
                            for (int e = 1; e < 16; ++e) mx = fmaxf(mx, fmaxf(sc0[e], sc1[e]));
                            mx = fmaxf(mx, __shfl_xor(mx, 32));
                            const float mn = sel ? fmaxf(m, mx) : m; const float alpha = __builtin_amdgcn_exp2f(m - mn); l *= alpha; m = mn;
#pragma unroll
                            for (int e = 0; e < 16; ++e) { o0[e] *= alpha; o1[e] *= alpha; }
                            continue; }
                        const float me = sel ? m : 1.0e30f; float tsum = 0.f;
#pragma unroll
                        for (int e = 0; e < 16; ++e) { sc0[e] = __builtin_amdgcn_exp2f(sc0[e] - me); sc1[e] = __builtin_amdgcn_exp2f(sc1[e] - me); tsum += sc0[e] + sc1[e]; }
                        if (attempt == 2 || __ballot(!(tsum <= 4096.f)) == 0ull) { l += tsum; break; }
                    }
#undef QK_TILE
                    const unsigned vb = lbase + A_V + cb * RB;
#pragma unroll
                    for (int mt = 0; mt < (VAR == 7 ? 0 : 2); ++mt) {
                        s16x4 x0, x1, x2, x3, x4, x5, x6, x7; const unsigned va0 = vb + 4096 * mt + lbV0, va1 = vb + 4096 * mt + 1024 + lbV1;
                        asm volatile("ds_read_b64_tr_b16 %0, %8\n\tds_read_b64_tr_b16 %1, %9\n\tds_read_b64_tr_b16 %2, %8 offset:512\n\tds_read_b64_tr_b16 %3, %9 offset:512\n\t"
                                     "ds_read_b64_tr_b16 %4, %8 offset:2048\n\tds_read_b64_tr_b16 %5, %9 offset:2048\n\tds_read_b64_tr_b16 %6, %8 offset:2560\n\tds_read_b64_tr_b16 %7, %9 offset:2560\n\ts_waitcnt lgkmcnt(0)"
                                     : "=&v"(x0), "=&v"(x1), "=&v"(x2), "=&v"(x3), "=&v"(x4), "=&v"(x5), "=&v"(x6), "=&v"(x7) : "v"(va0), "v"(va1) : "memory");
                        const bf16x8 f00 = __builtin_shufflevector(x0, x1, 0, 1, 2, 3, 4, 5, 6, 7), f01 = __builtin_shufflevector(x2, x3, 0, 1, 2, 3, 4, 5, 6, 7);
                        const bf16x8 f10 = __builtin_shufflevector(x4, x5, 0, 1, 2, 3, 4, 5, 6, 7), f11 = __builtin_shufflevector(x6, x7, 0, 1, 2, 3, 4, 5, 6, 7);
                        const bf16x8 pa = pack8(mt ? sc1 : sc0, 0), pb = pack8(mt ? sc1 : sc0, 1);
                        o0 = mfma32(f00, pa, o0); o1 = mfma32(f01, pa, o1); o0 = mfma32(f10, pb, o0); o1 = mfma32(f11, pb, o1); }
                    if (VAR == 7) { o0[0] += sc0[3] + sc1[5]; o1[1] += sc0[7] * sc1[9]; }
                }
                }
            }
            __builtin_amdgcn_s_barrier(); asm volatile("" ::: "memory");
#undef TILE_OF
#undef DMA_TILE
            const float gsel = 1.0f / (1.0f + __expf(-bf2f(PROJ[(size_t)tok * LDP + C_GR + head * 3 + 1 + br])));
            const float sc = gsel / (l + __shfl_xor(l, 32));
            float* op = ONSA + (size_t)tok * 1024 + head * 64 + 4 * h;
#pragma unroll
            for (int gq = 0; gq < 4; ++gq) { const f32x4 c0 = *(const f32x4*)(op + 8 * gq), c1 = *(const f32x4*)(op + 32 + 8 * gq);
                *(f32x4*)(op + 8 * gq) = (f32x4){c0.x + sc * o0[4 * gq], c0.y + sc * o0[4 * gq + 1], c0.z + sc * o0[4 * gq + 2], c0.w + sc * o0[4 * gq + 3]};
                *(f32x4*)(op + 32 + 8 * gq) = (f32x4){c1.x + sc * o1[4 * gq], c1.y + sc * o1[4 * gq + 1], c1.z + sc * o1[4 * gq + 2], c1.w + sc * o1[4 * gq + 3]}; }
            asm volatile("s_waitcnt vmcnt(0)" ::: "memory");
        }
    }
#endif
}

__device__ __forceinline__ void cmp_layer2(Frame& F, int b, int g) {
    const int lane = F.lane, br = F.wave >> 2, fr = lane & 15, fq = lane >> 4;
    const bf16* hid = (const bf16*)(F.ws + WS_HIDC) + (size_t)((br * 16 + g * 4 + b) * 256 + (F.wave & 3) * 64) * 256;
    const bf16* w2t = (const bf16*)(F.ws + (br ? SM_W2VT : SM_W2KT));
    bf16* outp = (bf16*)(F.ws + (br ? WS_VC : WS_KC));
    f32x4 acc[4][4];
#pragma unroll
    for (int m = 0; m < 4; ++m)
#pragma unroll
        for (int n = 0; n < 4; ++n) acc[m][n] = (f32x4){0.f, 0.f, 0.f, 0.f};
#pragma unroll 2
    for (int ks = 0; ks < 8; ++ks) { bf16x8 af[4], bfr[4];
#pragma unroll
        for (int m = 0; m < 4; ++m) af[m] = *(const bf16x8*)(hid + (size_t)(16 * m + fr) * 256 + 32 * ks + 8 * fq);
#pragma unroll
        for (int n = 0; n < 4; ++n) bfr[n] = *(const bf16x8*)(w2t + (size_t)(16 * n + fr) * 256 + 32 * ks + 8 * fq);
#pragma unroll
        for (int m = 0; m < 4; ++m)
#pragma unroll
            for (int n = 0; n < 4; ++n) acc[m][n] = __builtin_amdgcn_mfma_f32_16x16x32_bf16(af[m], bfr[n], acc[m][n], 0, 0, 0); }
#pragma unroll
    for (int m = 0; m < 4; ++m)
#pragma unroll
        for (int n = 0; n < 4; ++n)
#pragma unroll
            for (int i = 0; i < 4; ++i) { const int c = (F.wave & 3) * 64 + 16 * m + 4 * fq + i; outp[((size_t)(b * 256 + c) * 4 + g) * 64 + 16 * n + fr] = (bf16)f2bf(acc[m][n][i]); }
    VM_WAIT(); __syncthreads();
}
template <int VAR> __device__ __forceinline__ void attn_phase(Frame& F) {
    for (int wg = F.vcu; wg < 256; wg += F.G) { const int bg = wg >> 4, i = wg & 15, b = bg >> 2, g = bg & 3;
#if !NAIVE_CMP
        if (VAR == 0) cmp_layer2(F, b, g);
#endif
        {
            const bf16* KC = (const bf16*)(F.ws + WS_KC); const bf16* VC = (const bf16*)(F.ws + WS_VC); LAS unsigned char* L = F.lds;
            const int spc = F.tid & 7;
#pragma unroll
            for (int q = 0; q < 4; ++q) { const int c = (F.tid >> 3) + 64 * q; v4u kv = (v4u){0u, 0u, 0u, 0u}, vv = (v4u){0u, 0u, 0u, 0u};
                if (c < 255) { kv = *(const v4u*)(KC + ((size_t)(b * 256 + c) * 4 + g) * 64 + spc * 8); vv = *(const v4u*)(VC + ((size_t)(b * 256 + c) * 4 + g) * 64 + spc * 8); }
                *(LAS v4u*)(L + C_KI + c * KP + spc * 16) = kv; *(LAS v4u*)(L + C_VX + c * PH + spc * 16) = vv;
                unsigned ag[4];
#pragma unroll
                for (int jj = 0; jj < 4; ++jj) { const int j0 = 8 * spc + 2 * jj, j1 = j0 + 1; ag[jj] = ((c >= 4 * j0 - 1 && c <= 4 * j0 + 3 && c < 255) ? 0x3F80u : 0u) | ((c >= 4 * j1 - 1 && c <= 4 * j1 + 3 && c < 255) ? 0x3F800000u : 0u); }
                *(LAS v4u*)(L + C_VX + c * PH + 128 + spc * 16) = (v4u){ag[0], ag[1], ag[2], ag[3]}; }
            __syncthreads();
        }
#pragma unroll 1
        for (int u = 0; u < 4; ++u) { const int qb = (u == 0) ? 63 - i : (u == 1) ? 32 + i : (u == 2) ? 31 - i : i; if (VAR < 5) attn_cmp_unit<VAR>(F, b, g, qb, u); }
        VM_WAIT(); __syncthreads();
#pragma unroll 1
        for (int u = 0; u < 4; ++u) { const int qb = (u == 0) ? 63 - i : (u == 1) ? 32 + i : (u == 2) ? 31 - i : i; if (VAR != 4) attn_stream_unit<VAR>(F, b, g, qb, u); } }
}
__device__ __forceinline__ void n4_nsanorm(Frame& F) {
    const float* ONSA = (const float*)(F.ws + WS_ONSA); bf16* Y = (bf16*)(F.ws + WS_B); const float* gain = F.in[IN_NSA_NORM];
    const int gw = F.vcu * NWAVES + F.wave, NGW = F.G * NWAVES;
    for (int tok = gw; tok < NTOK; tok += NGW) {
        const f32x4* xr = (const f32x4*)(ONSA + (size_t)tok * 1024) + F.lane; const f32x4* gr = (const f32x4*)gain + F.lane;
        f32x4 v[4]; float s = 0.f;
#pragma unroll
        for (int j = 0; j < 4; ++j) { v[j] = xr[64 * j]; s += (v[j].x * v[j].x + v[j].y * v[j].y) + (v[j].z * v[j].z + v[j].w * v[j].w); }
        const float rstd = 1.0f / sqrtf(wave_sum(s) * (1.f / 1024.f) + EPS);
        unsigned long long* o8 = (unsigned long long*)(Y + (size_t)tok * DM + 1024) + F.lane;
#pragma unroll
        for (int j = 0; j < 4; ++j) { const f32x4 g = gr[64 * j]; o8[64 * j] = (unsigned long long)pk2(v[j].x * rstd * g.x, v[j].y * rstd * g.y) | ((unsigned long long)pk2(v[j].z * rstd * g.z, v[j].w * rstd * g.w) << 32); }
    }
}
__device__ __forceinline__ void p6_router(Frame& F) {
    const float* X2 = F.out;
    int* EID = (int*)(F.ws + SM_EID); float* EW = (float*)(F.ws + SM_EW); float* RSTD = (float*)(F.ws + SM_RSTD);
    const int gw = F.vcu * NWAVES + F.wave, NGW = F.G * NWAVES;
    {
        LAS float* scr = (LAS float*)(F.lds + RING_OFF + F.wave * 16384);
        bf16* WGUT = (bf16*)(F.ws + WS_WGUT); bf16* WDT = (bf16*)(F.ws + WS_WDT);
        for (int rep = 0; rep < (DUP == 60 ? 2 : 1); ++rep)
        for (int it = gw; it < 3 * 16384; it += NGW) { const int which = it >> 14, r = it & 16383, e = r >> 9, q = r & 511;
            if (which < 2) transpose_item(F.in[which ? IN_W_UP : IN_W_GATE] + (size_t)e * DM * 512, 512, 512, WGUT + (size_t)e * 1024 * DM, DM, scr, 64 * (q >> 4), 32 * (q & 15), F.lane, which ? 4 : 0);
            else transpose_item(F.in[IN_W_DOWN] + (size_t)e * 512 * DM, DM, DM, WDT + (size_t)e * DM * 512, 512, scr, 64 * (q >> 6), 32 * (q & 63), F.lane); }
    }
    const bf16* RTH = (const bf16*)(F.ws + SM_RTH); const bf16* RTL = (const bf16*)(F.ws + SM_RTL);
    LAS float* LG = (LAS float*)(F.lds + RING_OFF + (F.wave >> 1) * 8192);
    const int fr = F.lane & 15, fq = F.lane >> 4, kh = F.wave & 1;
    for (int rep = 0; rep < (DUP == 61 ? 2 : 1); ++rep)
    for (int g0 = F.vcu * 4; g0 < NTOK / 16; g0 += F.G * 4) { const int grp = g0 + (F.wave >> 1);
        const float* xr = X2 + (size_t)(grp * 16 + fr) * DM + kh * 1024 + 8 * fq;
        f32x4 acc[3]; float ssq = 0.f;
#pragma unroll
        for (int n = 0; n < 3; ++n) acc[n] = (f32x4){0.f, 0.f, 0.f, 0.f};
#pragma unroll 2
        for (int ks = 0; ks < 32; ++ks) { const f32x4 xa = *(const f32x4*)(xr + 32 * ks), xb = *(const f32x4*)(xr + 32 * ks + 4);
            ssq += (xa.x * xa.x + xa.y * xa.y) + (xa.z * xa.z + xa.w * xa.w) + (xb.x * xb.x + xb.y * xb.y) + (xb.z * xb.z + xb.w * xb.w);
            v4u ph, pl;
            { const unsigned h0 = f2bf(xa.x), h1 = f2bf(xa.y), h2 = f2bf(xa.z), h3 = f2bf(xa.w), h4 = f2bf(xb.x), h5 = f2bf(xb.y), h6 = f2bf(xb.z), h7 = f2bf(xb.w);
              ph.x = h0 | (h1 << 16); ph.y = h2 | (h3 << 16); ph.z = h4 | (h5 << 16); ph.w = h6 | (h7 << 16);
              pl.x = pk2(xa.x - bf2f(h0), xa.y - bf2f(h1)); pl.y = pk2(xa.z - bf2f(h2), xa.w - bf2f(h3)); pl.z = pk2(xb.x - bf2f(h4), xb.y - bf2f(h5)); pl.w = pk2(xb.z - bf2f(h6), xb.w - bf2f(h7)); }
            const bf16x8 ahi = __builtin_bit_cast(bf16x8, ph), alo = __builtin_bit_cast(bf16x8, pl);
#pragma unroll
            for (int n = 0; n < 3; ++n) { const size_t wo = (size_t)(16 * n + fr) * DM + kh * 1024 + 32 * ks + 8 * fq; const bf16x8 bh = *(const bf16x8*)(RTH + wo), bl = *(const bf16x8*)(RTL + wo);
                acc[n] = __builtin_amdgcn_mfma_f32_16x16x32_bf16(ahi, bh, acc[n], 0, 0, 0); acc[n] = __builtin_amdgcn_mfma_f32_16x16x32_bf16(alo, bh, acc[n], 0, 0, 0); acc[n] = __builtin_amdgcn_mfma_f32_16x16x32_bf16(ahi, bl, acc[n], 0, 0, 0); } }
        ssq += __shfl_xor(ssq, 16); ssq += __shfl_xor(ssq, 32);
#pragma unroll
        for (int n = 0; n < 3; ++n)
#pragma unroll
            for (int i = 0; i < 4; ++i) LG[kh * 768 + (4 * fq + i) * 48 + 16 * n + fr] = acc[n][i];
        if (fq == 0) LG[1536 + kh * 16 + fr] = ssq;
        __syncthreads();
        if (kh == 0 && F.lane < 16) {
            const int tok = grp * 16 + F.lane; const LAS float* L = LG + F.lane * 48;
            const float rstd = 1.0f / sqrtf((LG[1536 + F.lane] + LG[1552 + F.lane]) * (1.f / DM) + EPS);
            float gl[4];
#pragma unroll
            for (int i = 0; i < 4; ++i) gl[i] = (L[i] + L[768 + i]) * rstd + F.in[IN_B_GROUP][i];
            int gs = 0; float gm = gl[0];
#pragma unroll
            for (int i = 1; i < 4; ++i) if (gl[i] > gm) { gm = gl[i]; gs = i; }
            float den = 0.f;
#pragma unroll
            for (int i = 0; i < 4; ++i) den += expf(gl[i] - gm);
            const float gwt = 1.0f / den;
            float el[8];
#pragma unroll
            for (int i = 0; i < 8; ++i) el[i] = (L[4 + gs * 8 + i] + L[768 + 4 + gs * 8 + i]) * rstd + F.in[IN_B_ROUTER][gs * 8 + i];
            int i1 = 0; float v1 = el[0];
#pragma unroll
            for (int i = 1; i < 8; ++i) if (el[i] > v1) { v1 = el[i]; i1 = i; }
            int i2 = -1; float v2 = -3.0e38f;
#pragma unroll
            for (int i = 0; i < 8; ++i) if (i != i1 && el[i] > v2) { v2 = el[i]; i2 = i; }
            const float e2 = expf(v2 - v1), w1 = gwt / (1.0f + e2), w2 = gwt * e2 / (1.0f + e2);
            const int id1 = gs * 8 + i1, id2 = gs * 8 + i2;
            EID[tok * 2] = id1; EID[tok * 2 + 1] = id2; EW[tok * 2] = w1; EW[tok * 2 + 1] = w2; RSTD[tok] = rstd;
            if (rep == 0) { __hip_atomic_fetch_add(F.ctl + CW_CNT + id1, 1u, RLX_AGENT); __hip_atomic_fetch_add(F.ctl + CW_CNT + id2, 1u, RLX_AGENT); }
        }
        __syncthreads();
    }
}
__device__ __forceinline__ void p7_assign(Frame& F) {
    LAS int* pst = (LAS int*)(F.lds);
    if (F.tid == 0) { int acc = 0; for (int e = 0; e < 32; ++e) { const int c = (int)__hip_atomic_load(F.ctl + CW_CNT + e, RLX_AGENT); pst[e] = acc; pst[64 + e] = c; acc += ((c + 255) >> 8) << 8; } pst[32] = acc; }
    __syncthreads();
    int* TILEE = (int*)(F.ws + SM_TILEE);
    if (F.vcu == 0 && F.tid <= MAXTILE) { const int tl = F.tid; int e = -1;
        if (tl == MAXTILE) { TILEE[MAXTILE] = pst[32] >> 8; }
        else { for (int k = 0; k < 32; ++k) if ((pst[k] >> 8) <= tl && tl < (pst[k + 1] >> 8)) e = k; TILEE[tl] = e; } }
    if (F.vcu == 0 && F.tid < 64) { int* CNT = TILEE + 192; if (F.tid < 32) { CNT[F.tid] = pst[64 + F.tid]; CNT[32 + F.tid] = pst[F.tid]; } }
    const int* EID = (const int*)(F.ws + SM_EID); const float* EW = (const float*)(F.ws + SM_EW);
    int* TSLOT = (int*)(F.ws + SM_TSLOT); int* STOK = (int*)(F.ws + SM_STOK); float* SW = (float*)(F.ws + SM_SW);
    bf16* XG = (bf16*)(F.ws + WS_XG); const float* RSTD = (const float*)(F.ws + SM_RSTD); float* SRS = (float*)(F.ws + SM_SRS); const float* gain = F.in[IN_FFN_NORM];
    const int gw = F.vcu * NWAVES + F.wave, NGW = F.G * NWAVES;
    for (int rep = 0; rep < (DUP == 70 ? 2 : 1); ++rep)
    for (int tok = gw; tok < NTOK; tok += NGW) {
        int slot = 0;
        if (F.lane < 2) { if (rep == 0) { const int e = EID[tok * 2 + F.lane]; const int p = (int)__hip_atomic_fetch_add(F.ctl + CW_CUR + e, 1u, RLX_AGENT); slot = pst[e] + p;
            STOK[slot] = tok; SW[slot] = EW[tok * 2 + F.lane]; SRS[slot] = RSTD[tok]; TSLOT[tok * 2 + F.lane] = slot; } else slot = TSLOT[tok * 2 + F.lane]; }
        const int s0 = __shfl(slot, 0), s1 = __shfl(slot, 1);
        const f32x4* xr = (const f32x4*)(F.out + (size_t)tok * DM) + F.lane; const f32x4* gr = (const f32x4*)gain + F.lane;
        v2u* d0 = (v2u*)(XG + (size_t)s0 * DM) + F.lane; v2u* d1 = (v2u*)(XG + (size_t)s1 * DM) + F.lane;
#pragma unroll
        for (int j = 0; j < 8; ++j) { const f32x4 x = xr[64 * j], g = gr[64 * j]; v2u w; w.x = pk2(x.x * g.x, x.y * g.y); w.y = pk2(x.z * g.z, x.w * g.w); d0[64 * j] = w; d1[64 * j] = w; }
    }
}
__device__ __forceinline__ void n8_moe(Frame& F) {
    const int* TILEE = (const int*)(F.ws + SM_TILEE); const int* CNT = TILEE + 192; const float* SW = (const float*)(F.ws + SM_SW);
    bf16* XG = (bf16*)(F.ws + WS_XG);
    LAS float* xs = (LAS float*)(F.lds); LAS float* hs = xs + 16384;
    const int ntiles = TILEE[MAXTILE];
    for (int item = F.vcu; item < ntiles * 32; item += F.G) {
        const int e = TILEE[item >> 5], s0 = item * 8; const int nvalid = CNT[e] - (s0 - CNT[32 + e]);
        if (nvalid <= 0) continue;
        for (int idx = F.tid; idx < 16384; idx += 512) { const int r = idx >> 11, d = idx & 2047; xs[d * 8 + r] = (r < nvalid) ? bf2f(XG[(size_t)(s0 + r) * DM + d]) : 0.f; }
        __syncthreads();
        const float* Wg = F.in[IN_W_GATE] + (size_t)e * DM * 512 + F.tid; const float* Wu = F.in[IN_W_UP] + (size_t)e * DM * 512 + F.tid;
        float ag[8], au[8];
#pragma unroll
        for (int r = 0; r < 8; ++r) { ag[r] = 0.f; au[r] = 0.f; }
        for (int d = 0; d < DM; ++d) { const float wgv = Wg[(size_t)d * 512], wuv = Wu[(size_t)d * 512]; const f32x4 x0 = *(const LAS f32x4*)(xs + d * 8), x1 = *(const LAS f32x4*)(xs + d * 8 + 4);
#pragma unroll
            for (int r = 0; r < 4; ++r) { ag[r] += x0[r] * wgv; au[r] += x0[r] * wuv; ag[4 + r] += x1[r] * wgv; au[4 + r] += x1[r] * wuv; } }
#pragma unroll
        for (int r = 0; r < 8; ++r) hs[F.tid * 8 + r] = (ag[r] / (1.0f + __expf(-ag[r]))) * au[r];
        __syncthreads();
        const float* Wd = F.in[IN_W_DOWN] + (size_t)e * 512 * DM + F.tid;
        float acc[4][8];
#pragma unroll
        for (int i = 0; i < 4; ++i)
#pragma unroll
            for (int r = 0; r < 8; ++r) acc[i][r] = 0.f;
        for (int j = 0; j < 512; ++j) { const f32x4 h0 = *(const LAS f32x4*)(hs + j * 8), h1 = *(const LAS f32x4*)(hs + j * 8 + 4);
#pragma unroll
            for (int i = 0; i < 4; ++i) { const float w = Wd[(size_t)j * DM + 512 * i];
#pragma unroll
                for (int r = 0; r < 4; ++r) { acc[i][r] += h0[r] * w; acc[i][4 + r] += h1[r] * w; } } }
#pragma unroll
        for (int r = 0; r < 8; ++r) if (r < nvalid) { const float w = SW[s0 + r];
#pragma unroll
            for (int i = 0; i < 4; ++i) XG[(size_t)(s0 + r) * DM + F.tid + 512 * i] = (bf16)f2bf(acc[i][r] * w); }
        __syncthreads();
    }
}
__device__ __forceinline__ void p10_final(Frame& F) {
    const int* TSLOT = (const int*)(F.ws + SM_TSLOT); const bf16* YD = (const bf16*)(F.ws + WS_XG); const float* gain = F.in[IN_FINAL_NORM];
    const int gw = F.vcu * NWAVES + F.wave, NGW = F.G * NWAVES;
    for (int rep = (DUP == 100 ? 0 : 1); rep < 2; ++rep)
    for (int tok = gw; tok < NTOK; tok += NGW) {
        const int s0 = TSLOT[tok * 2], s1 = TSLOT[tok * 2 + 1];
        f32x4* xr = (f32x4*)(F.out + (size_t)tok * DM) + F.lane; const f32x4* gr = (const f32x4*)gain + F.lane;
        const v2u* y0 = (const v2u*)(YD + (size_t)s0 * DM) + F.lane; const v2u* y1 = (const v2u*)(YD + (size_t)s1 * DM) + F.lane;
        f32x4 v[8]; float s = 0.f;
#pragma unroll
        for (int j = 0; j < 8; ++j) { v[j] = xr[64 * j]; const v2u a = y0[64 * j], b = y1[64 * j];
            v[j].x = (v[j].x + bflo(a.x)) + bflo(b.x); v[j].y = (v[j].y + bfhi(a.x)) + bfhi(b.x); v[j].z = (v[j].z + bflo(a.y)) + bflo(b.y); v[j].w = (v[j].w + bfhi(a.y)) + bfhi(b.y);
            s += (v[j].x * v[j].x + v[j].y * v[j].y) + (v[j].z * v[j].z + v[j].w * v[j].w); }
        const float rstd = 1.0f / sqrtf(wave_sum(s) * (1.f / DM) + EPS);
#pragma unroll
        for (int j = 0; j < 8; ++j) { const f32x4 g = gr[64 * j]; if (rep == 1 || rstd == 12345.678f) xr[64 * j] = (f32x4){v[j].x * rstd * g.x, v[j].y * rstd * g.y, v[j].z * rstd * g.z, v[j].w * rstd * g.w}; }
    }
}

constexpr int N_PHASES = 11;
struct Args { const float* in[22]; float* out; unsigned char* ws; int ph_lo, ph_hi; };
__global__ void __launch_bounds__(NWAVES * 64, 2) fwd(Args args) {
    extern __shared__ __attribute__((aligned(16))) unsigned char lds[];
    Frame F;
    F.lds = (LAS unsigned char*)lds;
    F.MISC = (volatile LAS unsigned*)(F.lds + MISC_OFF);
    F.tid = threadIdx.x; F.lane = F.tid & 63; F.wave = __builtin_amdgcn_readfirstlane(F.tid >> 6);
    F.G = gridDim.x; { const int bx = blockIdx.x; F.vcu = (F.G % 8 == 0) ? (bx % 8) * (F.G / 8) + bx / 8 : bx; }
#pragma unroll
    for (int i = 0; i < 22; ++i) F.in[i] = args.in[i];
    F.out = args.out; F.ws = args.ws; F.ctl = (gu32*)(args.ws + WS_CTL);
    for (int u = F.tid; u < (LDS_BYTES - LDSCTL_OFF) / 4; u += NWAVES * 64) ((LAS unsigned*)(F.lds + LDSCTL_OFF))[u] = 0u;
    __syncthreads();
    const int lo = args.ph_lo, hi = args.ph_hi;
    const bool multi = (hi - lo) > 1;
    XcdBarrier bar; bar.bar = (unsigned*)(F.ctl + CW_BAR); bar.x = 0; bar.st = nullptr;
    if (multi) bar = xcd_barrier_post((unsigned*)(F.ctl + CW_BAR), F.MISC + 8);
#define IN(k) (((PHMASK >> (k)) & 1) && lo <= (k) && (k) < hi)
#define SEAM(k) do { if (IN(k) && IN((k) + 1)) xcd_barrier(bar); } while (0)
    if (IN(0)) { p0_prologue(F); if (DUP == 0) { __syncthreads(); p0_prologue(F); } } SEAM(0);
    if (IN(1)) {
        pg8::Gemm g{DM, DM * 2, DM * 2, 128}; pg8::DenseOrder S; S.init(F.ws + WS_B, F.ws + WS_WINT, NTOK, LDP, DM * 2, DM * 2, F.G, (int)blockIdx.x);
        pg8::EpiBf16<0> E{(pg8::bf16_t*)(F.ws + WS_PROJ), LDP, nullptr};
        pg8::gemm_phase<pg8::EpiBf16<0>, pg8::DenseOrder, true, true>(F.lds + RING_OFF, g, S, E);
        if (DUP == 1) { __syncthreads(); pg8::gemm_phase<pg8::EpiBf16<0>, pg8::DenseOrder, true, true>(F.lds + RING_OFF, g, S, E); }
    } SEAM(1);
#if NAIVE_HGRN
    if (IN(2)) { n2_rope_compress(F); } SEAM(2);
    if (IN(3)) { n3_mixers(F); } SEAM(3);
    if (IN(4)) { n4_nsanorm(F); } SEAM(4);
#else
    if (IN(2)) {
#if !NAIVE_CMP
        if (F.vcu < 32) {
            const int br = F.vcu >> 4; const float* BP = (const float*)(F.ws + SM_BPART) + br * 32 * 256;
            if (F.tid < 256) { float s = 0.f;
#pragma unroll 8
                for (int ch = 0; ch < 32; ++ch) s += BP[ch * 256 + F.tid];
                ((float*)(F.ws + (br ? SM_B1V : SM_B1K)))[F.tid] = s; }
            VM_WAIT(); __syncthreads(); }
        {
            pg8::Gemm g{DM, 16 * LDP * 2, DM * 2, LDP * 2}; pg8::CmpOrder S{F.vcu, (const char*)(F.ws + WS_PROJ), (const char*)(F.ws + SM_W1KT), (const char*)(F.ws + SM_W1VT), (size_t)LDP * 2, C_KC * 2, C_VC * 2};
            pg8::EpiCmp E{(pg8::bf16_t*)(F.ws + WS_HIDC), (const float*)(F.ws + SM_B1K), (const float*)(F.ws + SM_B1V)};
            pg8::gemm_phase<pg8::EpiCmp, pg8::CmpOrder, true, true>(F.lds + RING_OFF, g, S, E);
            __syncthreads();
            if (DUP == 20) { pg8::gemm_phase<pg8::EpiCmp, pg8::CmpOrder, true, true>(F.lds + RING_OFF, g, S, E); __syncthreads(); }
        }
#endif
        if (DUP == 21) hgrn_passA<false>(F);
        hgrn_passA<true>(F); n2_rope_compress(F); } SEAM(2);
#if NAIVE_ATTN
    if (IN(3)) { hgrn_scan(F); n3_mixers(F); } SEAM(3);
#else
    if (IN(3)) { hgrn_scan(F); if (DUP == 30) hgrn_scan(F); attn_phase<0>(F); if (DUP == 3) { __syncthreads(); attn_phase<0>(F); } if (DUP == 34) { __syncthreads(); attn_phase<4>(F); } if (DUP == 35) { __syncthreads(); attn_phase<5>(F); } if (DUP == 36) { __syncthreads(); attn_phase<6>(F); } if (DUP == 37) { __syncthreads(); attn_phase<7>(F); } } SEAM(3);
#endif
    if (IN(4)) { hgrn_passB(F); n4_nsanorm(F); if (DUP == 4) { __syncthreads(); hgrn_passB(F); n4_nsanorm(F); } } SEAM(4);
#endif
    if (IN(5)) {
        pg8::Gemm g{DM, DM * 2, DM * 2, 128}; pg8::DenseOrder S; S.init(F.ws + WS_B, F.ws + WS_WOT, NTOK, DM, DM * 2, DM * 2, F.G, (int)blockIdx.x);
        pg8::EpiResF32 E{F.in[IN_X], F.out, DM};
        pg8::gemm_phase<pg8::EpiResF32, pg8::DenseOrder, true, true>(F.lds + RING_OFF, g, S, E);
        if (DUP == 5) { __syncthreads(); pg8::gemm_phase<pg8::EpiResF32, pg8::DenseOrder, true, true>(F.lds + RING_OFF, g, S, E); }
    } SEAM(5);
    if (IN(6)) { p6_router(F); } SEAM(6);
    if (IN(7)) { p7_assign(F); } SEAM(7);
#if NAIVE_MOE
    if (IN(8)) { n8_moe(F); } SEAM(8); SEAM(9);
#else
    if (IN(8)) {
        const int* TILEE = (const int*)(F.ws + SM_TILEE);
        pg8::Gemm g{DM, DM * 2, DM * 2, 128}; pg8::MoeOrder S; S.init(F.ws + WS_XG, F.ws + WS_WGUT, TILEE, TILEE[MAXTILE], 4, DM * 2, DM * 2, 1024, F.G, F.vcu);
        pg8::EpiSwiGLU E{(pg8::bf16_t*)(F.ws + WS_HIDM), 512, (const float*)(F.ws + SM_SRS)};
        pg8::gemm_phase<pg8::EpiSwiGLU, pg8::MoeOrder, true, true>(F.lds + RING_OFF, g, S, E);
        if (DUP == 8) { __syncthreads(); pg8::gemm_phase<pg8::EpiSwiGLU, pg8::MoeOrder, true, true>(F.lds + RING_OFF, g, S, E); }
    } SEAM(8);
    if (IN(9)) {
        const int* TILEE = (const int*)(F.ws + SM_TILEE);
        pg8::Gemm g{512, 512 * 2, 512 * 2, 128}; pg8::MoeOrder S; S.init(F.ws + WS_HIDM, F.ws + WS_WDT, TILEE, TILEE[MAXTILE], 8, 512 * 2, 512 * 2, DM, F.G, F.vcu);
        pg8::EpiRowScaleBf16 E{(pg8::bf16_t*)(F.ws + WS_XG), DM, (const float*)(F.ws + SM_SW)};
        pg8::gemm_phase<pg8::EpiRowScaleBf16, pg8::MoeOrder, true, true>(F.lds + RING_OFF, g, S, E);
        if (DUP == 9) { __syncthreads(); pg8::gemm_phase<pg8::EpiRowScaleBf16, pg8::MoeOrder, true, true>(F.lds + RING_OFF, g, S, E); }
    } SEAM(9);
#endif
    if (IN(10)) { p10_final(F); }
    if (DUP == 99 && multi) { xcd_barrier(bar); xcd_barrier(bar); xcd_barrier(bar); xcd_barrier(bar); }
#undef IN
#undef SEAM
}

extern "C" void kernel_launch(void* const* d_in, const int* in_sizes, int n_in, void* d_out, int out_size, void* d_ws, size_t ws_size, hipStream_t stream) {
    static int grid = 0;
    if (grid == 0) {
        if (n_in != 22 || out_size != NTOK * DM || ws_size < WS_END) { fprintf(stderr, "kernel_launch: unexpected shapes (n_in %d, out %d, ws %zu < %zu)\n", n_in, out_size, ws_size, (size_t)WS_END); grid = -1; return; }
        int dev = 0, cus = 0, per_cu = 0;
        if (hipGetDevice(&dev) != hipSuccess || hipDeviceGetAttribute(&cus, hipDeviceAttributeMultiprocessorCount, dev) != hipSuccess) { grid = -1; return; }
        if (hipFuncSetAttribute((const void*)fwd, hipFuncAttributeMaxDynamicSharedMemorySize, LDS_BYTES) != hipSuccess) { fprintf(stderr, "kernel_launch: hipFuncSetAttribute failed\n"); grid = -1; return; }
        if (hipOccupancyMaxActiveBlocksPerMultiprocessor(&per_cu, (const void*)fwd, NWAVES * 64, LDS_BYTES) != hipSuccess || per_cu < 1) { fprintf(stderr, "kernel_launch: occupancy query says %d\n", per_cu); }
        (void)hipGetLastError();
        grid = cus;
    }
    if (grid < 0) return;
    (void)hipMemsetAsync((char*)d_ws + WS_CTL, 0, CTL_ZERO_BYTES, stream);
    Args a{};
    for (int i = 0; i < 22; ++i) a.in[i] = (const float*)d_in[i];
    a.out = (float*)d_out; a.ws = (unsigned char*)d_ws;
#if MK_ONE_LAUNCH
    a.ph_lo = 0; a.ph_hi = N_PHASES;
    hipLaunchKernelGGL(fwd, dim3(grid), dim3(NWAVES * 64), LDS_BYTES, stream, a);
#else
    for (int p = 0; p < N_PHASES; ++p) { a.ph_lo = p; a.ph_hi = p + 1; hipLaunchKernelGGL(fwd, dim3(grid), dim3(NWAVES * 64), LDS_BYTES, stream, a); }
#endif
}
```

```cpp
#include <hip/hip_runtime.h>
#include <cstdio>
#include <cstdint>
namespace pg8 {
#define PG8_LAS __attribute__((address_space(3)))
typedef unsigned short bf16_t;
typedef short bf16x8 __attribute__((ext_vector_type(8)));
typedef float f32x4 __attribute__((ext_vector_type(4)));
typedef unsigned u32x4 __attribute__((ext_vector_type(4)));
constexpr int BM = 256, BK = 64, HALF = 128, HTB = HALF * BK * 2  , STAGE_BYTES = 8 * HTB, NXCD = 8, WGM = 8;

__host__ __device__ __forceinline__ int lds_byte(int r, int c) { const int st = (r >> 4) * 2 + (c >> 5), rr = r & 15, cc = c & 31, ob = rr * 64 + cc * 2; return st * 1024 + (ob ^ (((ob >> 9) & 1) << 5)); }
__host__ __device__ __forceinline__ void stage_rc(int b, int& R, int& C) { const int st = b / 1024, sb = b % 1024, swz = sb ^ (((sb >> 9) & 1) << 5); R = (st >> 1) * 16 + swz / 64; C = (st & 1) * 32 + (swz % 64) / 2; }
__host__ __device__ __forceinline__ int perm32(int rho) { const int n = rho >> 4, i = rho & 15; return 8 * (i >> 2) + 4 * n + (i & 3); }

typedef unsigned u32x2 __attribute__((ext_vector_type(2)));
struct Unit { int pm, pn; const char* a; const char* b; };
struct Gemm { int K; int lda, ldb, kstepA; };

struct DenseOrder {
    int nM, nN, nwg, G, c; const char* A; const char* B; size_t tA, tB;
    __device__ __forceinline__ void init(const void* A_, const void* B_, int M, int N, int lda, int ldb, int G_, int c_) {
        nM = M / BM; nN = N / BM; nwg = nM * nN; G = G_; c = c_; A = (const char*)A_; B = (const char*)B_; tA = (size_t)BM * lda; tB = (size_t)BM * ldb; }
    __device__ __forceinline__ bool next(int i, Unit& u) const {
        const long L = (long)i * G + c; if (L >= nwg) return false;
        int wgid = (int)L; { const int q = nwg / NXCD, r = nwg % NXCD, xcd = wgid % NXCD, off = wgid / NXCD; wgid = (xcd < r ? xcd * (q + 1) : r * (q + 1) + (xcd - r) * q) + off; }
        const int nig = WGM * nN, gid = wgid / nig, fm = gid * WGM, gsz = (nM - fm) < WGM ? (nM - fm) : WGM;
        u.pm = fm + ((wgid % nig) % gsz); u.pn = (wgid % nig) / gsz; u.a = A + (size_t)u.pm * tA; u.b = B + (size_t)u.pn * tB; return true;
    }
    __device__ __forceinline__ void a_ready(const Unit&) const {}
    __device__ __forceinline__ void done(const Unit&) const {}
};

__device__ __forceinline__ unsigned cvt_pk_bf16(float lo, float hi) { unsigned r; asm volatile("v_cvt_pk_bf16_f32 %0, %1, %2" : "=v"(r) : "v"(lo), "v"(hi)); return r; }
__device__ __forceinline__ float gelu_tanh(float x) {
    const float u = 0.7978845608f * (x + 0.044715f * x * x * x);
    return x / (1.0f + __expf(-2.0f * u));
}
template <int ACT> struct EpiBf16 {
    static constexpr bool PERM = true, AFTER_DRAIN = false;
    bf16_t* O; int ldc; const float* bias;
    __device__ __forceinline__ void operator()(const f32x4 (&acc)[2][2][4][2], const Unit& u, int wr, int wc, int fr, int fq) const {
        const int row0 = u.pm * BM + wr * 64 + fr; const int col0 = u.pn * BM + wc * 32 + 8 * fq;
        f32x4 bv[2][2];
#pragma unroll
        for (int bj = 0; bj < 2; ++bj)
#pragma unroll
            for (int n = 0; n < 2; ++n) bv[bj][n] = bias ? *(const f32x4*)(bias + col0 + bj * HALF + 4 * n) : (f32x4){0.f, 0.f, 0.f, 0.f};
#pragma unroll
        for (int ai = 0; ai < 2; ++ai)
#pragma unroll
            for (int m = 0; m < 4; ++m) { bf16_t* rowp = O + (size_t)(row0 + ai * HALF + m * 16) * ldc + col0;
#pragma unroll
                for (int bj = 0; bj < 2; ++bj) { f32x4 v0 = acc[ai][bj][m][0] + bv[bj][0], v1 = acc[ai][bj][m][1] + bv[bj][1];
                    if (ACT == 2) {
#pragma unroll
                        for (int j = 0; j < 4; ++j) { v0[j] = gelu_tanh(v0[j]); v1[j] = gelu_tanh(v1[j]); } }
                    u32x4 w; w.x = cvt_pk_bf16(v0[0], v0[1]); w.y = cvt_pk_bf16(v0[2], v0[3]); w.z = cvt_pk_bf16(v1[0], v1[1]); w.w = cvt_pk_bf16(v1[2], v1[3]);
                    *(u32x4*)(rowp + bj * HALF) = w; } }
    }
};
struct EpiResF32 {
    static constexpr bool PERM = false, AFTER_DRAIN = false;
    const float* base; float* C; int ldc;
    __device__ __forceinline__ void operator()(const f32x4 (&acc)[2][2][4][2], const Unit& u, int wr, int wc, int fr, int fq) const {
        const int row0 = u.pm * BM + wr * 64 + fr, col0 = u.pn * BM + wc * 32 + 4 * fq;
#pragma unroll
        for (int ai = 0; ai < 2; ++ai)
#pragma unroll
            for (int m = 0; m < 4; ++m) { const size_t off = (size_t)(row0 + ai * HALF + m * 16) * ldc + col0;
#pragma unroll
                for (int bj = 0; bj < 2; ++bj)
#pragma unroll
                    for (int n = 0; n < 2; ++n) { const f32x4 bs = *(const f32x4*)(base + off + bj * HALF + n * 16); *(f32x4*)(C + off + bj * HALF + n * 16) = bs + acc[ai][bj][m][n]; } }
    }
};


struct MoeOrder {
    int NC, G, c, nunits; const int* tile_e; const char* A; const char* B; size_t tA, tE, tN;
    __device__ __forceinline__ void init(const void* A_, const void* B_, const int* tile_e_, int ntiles, int NC_, int lda, int ldb, int rows_per_expert, int G_, int c_) {
        NC = NC_; G = G_; c = c_; nunits = ntiles * NC_; tile_e = tile_e_; A = (const char*)A_; B = (const char*)B_; tA = (size_t)BM * lda; tE = (size_t)rows_per_expert * ldb; tN = (size_t)BM * ldb; }
    __device__ __forceinline__ bool next(int i, Unit& u) const {
        const int L = i * G + c; if (L >= nunits) return false;
        u.pm = L / NC; u.pn = L % NC; const int e = tile_e[u.pm]; u.a = A + (size_t)u.pm * tA; u.b = B + (size_t)e * tE + (size_t)u.pn * tN; return true;
    }
    __device__ __forceinline__ void a_ready(const Unit&) const {}
    __device__ __forceinline__ void done(const Unit&) const {}
};
struct EpiSwiGLU {
    static constexpr bool PERM = true, AFTER_DRAIN = false;
    bf16_t* O; int ldc; const float* rowscale;
    __device__ __forceinline__ void operator()(const f32x4 (&acc)[2][2][4][2], const Unit& u, int wr, int wc, int fr, int fq) const {
        const int row0 = u.pm * BM + wr * 64 + fr; const int col0 = u.pn * 128 + wc * 16 + 4 * fq;
#pragma unroll
        for (int ai = 0; ai < 2; ++ai)
#pragma unroll
            for (int m = 0; m < 4; ++m) { const int row = row0 + ai * HALF + m * 16; const float rs = rowscale[row]; bf16_t* rowp = O + (size_t)row * ldc + col0;
#pragma unroll
                for (int bj = 0; bj < 2; ++bj) { const f32x4 g = acc[ai][bj][m][0] * rs, up = acc[ai][bj][m][1] * rs; float h[4];
#pragma unroll
                    for (int j = 0; j < 4; ++j) h[j] = g[j] / (1.0f + __expf(-g[j])) * up[j];
                    u32x2 w; w.x = cvt_pk_bf16(h[0], h[1]); w.y = cvt_pk_bf16(h[2], h[3]);
                    *(u32x2*)(rowp + bj * 64) = w; } }
    }
};
struct EpiRowScaleBf16 {
    static constexpr bool PERM = true, AFTER_DRAIN = false;
    bf16_t* O; int ldc; const float* rowscale;
    __device__ __forceinline__ void operator()(const f32x4 (&acc)[2][2][4][2], const Unit& u, int wr, int wc, int fr, int fq) const {
        const int row0 = u.pm * BM + wr * 64 + fr; const int col0 = u.pn * BM + wc * 32 + 8 * fq;
#pragma unroll
        for (int ai = 0; ai < 2; ++ai)
#pragma unroll
            for (int m = 0; m < 4; ++m) { const int row = row0 + ai * HALF + m * 16; const float sc = rowscale[row]; bf16_t* rowp = O + (size_t)row * ldc + col0;
#pragma unroll
                for (int bj = 0; bj < 2; ++bj) { const f32x4 v0 = acc[ai][bj][m][0] * sc, v1 = acc[ai][bj][m][1] * sc;
                    u32x4 w; w.x = cvt_pk_bf16(v0[0], v0[1]); w.y = cvt_pk_bf16(v0[2], v0[3]); w.z = cvt_pk_bf16(v1[0], v1[1]); w.w = cvt_pk_bf16(v1[2], v1[3]);
                    *(u32x4*)(rowp + bj * HALF) = w; } }
    }
};


struct CmpOrder {
    int c; const char* proj; const char* w1k; const char* w1v; size_t tokrow; int colk, colv;
    __device__ __forceinline__ bool next(int i, Unit& u) const {
        if (i != 0 || c >= 32) return false;
        const int br = c >> 4, g = (c >> 2) & 3, b = c & 3;
        u.pm = c; u.pn = 0; u.a = proj + (size_t)(b * 4096) * tokrow + (br ? colv : colk) + g * 128; u.b = br ? w1v : w1k; return true;
    }
    __device__ __forceinline__ void a_ready(const Unit&) const {}
    __device__ __forceinline__ void done(const Unit&) const {}
};
struct EpiCmp {
    static constexpr bool PERM = true, AFTER_DRAIN = false;
    bf16_t* O; const float* biask; const float* biasv;
    __device__ __forceinline__ void operator()(const f32x4 (&acc)[2][2][4][2], const Unit& u, int wr, int wc, int fr, int fq) const {
        const int row0 = u.pm * BM + wr * 64 + fr; const int col0 = wc * 32 + 8 * fq; const float* bias = (u.pm >= 16) ? biasv : biask;
        f32x4 bv[2][2];
#pragma unroll
        for (int bj = 0; bj < 2; ++bj)
#pragma unroll
            for (int n = 0; n < 2; ++n) bv[bj][n] = *(const f32x4*)(bias + col0 + bj * HALF + 4 * n);
#pragma unroll
        for (int ai = 0; ai < 2; ++ai)
#pragma unroll
            for (int m = 0; m < 4; ++m) { bf16_t* rowp = O + (size_t)(row0 + ai * HALF + m * 16) * 256 + col0;
#pragma unroll
                for (int bj = 0; bj < 2; ++bj) { f32x4 v0 = acc[ai][bj][m][0] + bv[bj][0], v1 = acc[ai][bj][m][1] + bv[bj][1];
#pragma unroll
                    for (int j = 0; j < 4; ++j) { v0[j] = gelu_tanh(v0[j]); v1[j] = gelu_tanh(v1[j]); }
                    u32x4 w; w.x = cvt_pk_bf16(v0[0], v0[1]); w.y = cvt_pk_bf16(v0[2], v0[3]); w.z = cvt_pk_bf16(v1[0], v1[1]); w.w = cvt_pk_bf16(v1[2], v1[3]);
                    *(u32x4*)(rowp + bj * HALF) = w; } }
    }
};

template <class Epi, class Sched, bool ALIGN_EPI = false, bool SP2 = false>
__device__ __forceinline__ void gemm_phase(PG8_LAS unsigned char* lds, const Gemm g, const Sched& S, const Epi& E) {
    const int tid = threadIdx.x, wid = __builtin_amdgcn_readfirstlane(tid >> 6), lane = tid & 63, wr = wid >> 2, wc = wid & 3, fr = lane & 15, fq = lane >> 4;
    const int K = g.K, nt = K / BK;
    unsigned voffA[2], voffB[2];
#pragma unroll
    for (int i = 0; i < 2; ++i) { int R, C; stage_rc(tid * 16 + i * 8192, R, C); const int Rb = Epi::PERM ? ((R & ~31) + perm32(R & 31)) : R;
        voffA[i] = (unsigned)(R * g.lda + C * 2); voffB[i] = (unsigned)(Rb * g.ldb + C * 2); }
    const size_t kstepA = (size_t)g.kstepA, kstepB = (size_t)(BK * 2);
    const size_t hstepA = (size_t)HALF * g.lda, hstepB = (size_t)HALF * g.ldb;
    const unsigned ldsw = (unsigned)wid * 1024u;
    const int aoff = lds_byte(wr * 64 + fr, fq * 8), boff = lds_byte(wc * 32 + fr, fq * 8);
#define PG8_SA(b, h) (((b) * 2 + (h)) * HTB)
#define PG8_SB(b, h) ((4 + (b) * 2 + (h)) * HTB)
#define PG8_STAGE(bufoff, gbase, voff) do { _Pragma("unroll") for (int _i = 0; _i < 2; ++_i) \
        __builtin_amdgcn_global_load_lds((const unsigned*)((const char*)(gbase) + (voff)[_i]), (PG8_LAS unsigned*)(lds + (bufoff) + ldsw + _i * 8192), 16, 0, 0); } while (0)
#define PG8_LDA(dst, b, h) do { _Pragma("unroll") for (int m = 0; m < 4; ++m) _Pragma("unroll") for (int k = 0; k < 2; ++k) dst[m][k] = *(const PG8_LAS bf16x8*)(lds + PG8_SA(b, h) + aoff + m * 2048 + k * 1024); } while (0)
#define PG8_LDB(dst, b, h) do { _Pragma("unroll") for (int n = 0; n < 2; ++n) _Pragma("unroll") for (int k = 0; k < 2; ++k) dst[n][k] = *(const PG8_LAS bf16x8*)(lds + PG8_SB(b, h) + boff + n * 2048 + k * 1024); } while (0)
#define PG8_MMA(ai, bj, At, Bt) do { __builtin_amdgcn_s_setprio(1); _Pragma("unroll") for (int m = 0; m < 4; ++m) _Pragma("unroll") for (int n = 0; n < 2; ++n) _Pragma("unroll") for (int k = 0; k < 2; ++k) \
        acc[ai][bj][m][n] = __builtin_amdgcn_mfma_f32_16x16x32_bf16(Bt[n][k], At[m][k], acc[ai][bj][m][n], 0, 0, 0); __builtin_amdgcn_s_setprio(0); } while (0)
#define PG8_WAIT_V(n) asm volatile("s_waitcnt vmcnt(" #n ")" ::: "memory")
#define PG8_WAIT_L(n) asm volatile("s_waitcnt lgkmcnt(" #n ")" ::: "memory")
#define PG8_BAR __builtin_amdgcn_s_barrier()
#define PG8_SCHED __builtin_amdgcn_sched_barrier(0)
    Unit cur, nxt; int ui = 0;
    if (!S.next(0, cur)) return;
    f32x4 acc[2][2][4][2];
#pragma unroll
    for (int a = 0; a < 2; ++a)
#pragma unroll
        for (int b = 0; b < 2; ++b)
#pragma unroll
            for (int m = 0; m < 4; ++m)
#pragma unroll
                for (int n = 0; n < 2; ++n) acc[a][b][m][n] = (f32x4){0.f, 0.f, 0.f, 0.f};
    bf16x8 At[4][2], B0[2][2], B1[2][2];
    const char* cA = cur.a; const char* cB = cur.b;
    S.a_ready(cur);
    if constexpr (SP2) {
        PG8_STAGE(PG8_SB(0, 0), cB, voffB); PG8_STAGE(PG8_SB(0, 1), cB + hstepB, voffB); PG8_STAGE(PG8_SA(0, 0), cA, voffA); PG8_STAGE(PG8_SA(0, 1), cA + hstepA, voffA);
        if (wr == 1) PG8_BAR;
        PG8_WAIT_V(2); PG8_BAR;
        PG8_STAGE(PG8_SB(1, 0), cB + kstepB, voffB); PG8_STAGE(PG8_SA(1, 0), cA + kstepA, voffA); PG8_STAGE(PG8_SB(1, 1), cB + hstepB + kstepB, voffB);
        PG8_WAIT_V(6); PG8_BAR;
    } else {
        PG8_STAGE(PG8_SB(0, 0), cB, voffB); PG8_STAGE(PG8_SA(0, 0), cA, voffA); PG8_STAGE(PG8_SB(0, 1), cB + hstepB, voffB); PG8_STAGE(PG8_SA(0, 1), cA + hstepA, voffA);
        if (wr == 1) PG8_BAR;
        PG8_WAIT_V(4); PG8_BAR;
        PG8_STAGE(PG8_SB(1, 0), cB + kstepB, voffB); PG8_STAGE(PG8_SA(1, 0), cA + kstepA, voffA); PG8_STAGE(PG8_SB(1, 1), cB + hstepB + kstepB, voffB);
        PG8_WAIT_V(6); PG8_BAR;
    }
    for (;;) {
        const bool has_next = S.next(ui + 1, nxt);
        const char* nA = has_next ? nxt.a : cA; const char* nB = has_next ? nxt.b : cB;
        for (int t = 0; t < nt; t += 2) {
            const bool last = (t == nt - 2);
            const char* a1 = cA + (size_t)(t + 1) * kstepA;
            const char* a2 = last ? nA : cA + (size_t)(t + 2) * kstepA; const char* b2 = last ? nB : cB + (size_t)(t + 2) * kstepB;
            const char* a3 = a2 + kstepA; const char* b3 = b2 + kstepB;
            if (last && has_next) S.a_ready(nxt);
            if constexpr (SP2) {
            PG8_LDB(B0, 0, 0); PG8_LDB(B1, 0, 1); PG8_SCHED; PG8_LDA(At, 0, 0); PG8_STAGE(PG8_SA(1, 1), a1 + hstepA, voffA);
            PG8_WAIT_V(8); PG8_WAIT_L(0); PG8_BAR; PG8_MMA(0, 0, At, B0); PG8_MMA(0, 1, At, B1); PG8_BAR; PG8_SCHED;
            PG8_LDA(At, 0, 1); PG8_STAGE(PG8_SB(0, 0), b2, voffB); PG8_STAGE(PG8_SB(0, 1), b2 + hstepB, voffB); PG8_STAGE(PG8_SA(0, 0), a2, voffA);
            PG8_WAIT_V(8); PG8_WAIT_L(0); PG8_BAR; PG8_MMA(1, 0, At, B0); PG8_MMA(1, 1, At, B1); PG8_BAR; PG8_SCHED;
            PG8_LDB(B0, 1, 0); PG8_LDB(B1, 1, 1); PG8_SCHED; PG8_LDA(At, 1, 0); PG8_STAGE(PG8_SA(0, 1), a2 + hstepA, voffA);
            PG8_WAIT_V(8); PG8_WAIT_L(0); PG8_BAR; PG8_MMA(0, 0, At, B0); PG8_MMA(0, 1, At, B1); PG8_BAR; PG8_SCHED;
            PG8_LDA(At, 1, 1); PG8_STAGE(PG8_SB(1, 0), b3, voffB); PG8_STAGE(PG8_SB(1, 1), b3 + hstepB, voffB); PG8_STAGE(PG8_SA(1, 0), a3, voffA);
            PG8_WAIT_V(8); PG8_WAIT_L(0); PG8_BAR; PG8_MMA(1, 0, At, B0); PG8_MMA(1, 1, At, B1); PG8_BAR; PG8_SCHED;
            } else {
            PG8_LDB(B0, 0, 0); PG8_SCHED; PG8_LDA(At, 0, 0); PG8_STAGE(PG8_SA(1, 1), a1 + hstepA, voffA);
            PG8_WAIT_L(8); PG8_BAR; PG8_WAIT_L(0); PG8_MMA(0, 0, At, B0); PG8_BAR; PG8_SCHED;
            PG8_LDB(B1, 0, 1); PG8_STAGE(PG8_SB(0, 0), b2, voffB);
            PG8_BAR; PG8_WAIT_L(0); PG8_MMA(0, 1, At, B1); PG8_BAR;
            PG8_LDA(At, 0, 1); PG8_STAGE(PG8_SA(0, 0), a2, voffA);
            PG8_BAR; PG8_WAIT_L(0); PG8_MMA(1, 0, At, B0); PG8_BAR; PG8_SCHED;
            PG8_STAGE(PG8_SB(0, 1), b2 + hstepB, voffB);
            PG8_WAIT_V(6); PG8_BAR; PG8_MMA(1, 1, At, B1); PG8_BAR;
            PG8_LDB(B0, 1, 0); PG8_SCHED; PG8_LDA(At, 1, 0); PG8_STAGE(PG8_SA(0, 1), a2 + hstepA, voffA);
            PG8_WAIT_L(8); PG8_BAR; PG8_WAIT_L(0); PG8_MMA(0, 0, At, B0); PG8_BAR; PG8_SCHED;
            PG8_LDB(B1, 1, 1); PG8_STAGE(PG8_SB(1, 0), b3, voffB);
            PG8_BAR; PG8_WAIT_L(0); PG8_MMA(0, 1, At, B1); PG8_BAR;
            PG8_LDA(At, 1, 1); PG8_STAGE(PG8_SA(1, 0), a3, voffA);
            PG8_BAR; PG8_WAIT_L(0); PG8_MMA(1, 0, At, B0); PG8_BAR; PG8_SCHED;
            PG8_STAGE(PG8_SB(1, 1), b3 + hstepB, voffB);
            PG8_WAIT_V(6); PG8_BAR; PG8_MMA(1, 1, At, B1); PG8_BAR;
            }
        }
        if constexpr (ALIGN_EPI) { if (wr == 0) PG8_BAR; }
        if constexpr (!Epi::AFTER_DRAIN) { E(acc, cur, wr, wc, fr, fq); S.done(cur); }
        if (!has_next) break;
#pragma unroll
        for (int a = 0; a < 2; ++a)
#pragma unroll
            for (int b = 0; b < 2; ++b)
#pragma unroll
                for (int m = 0; m < 4; ++m)
#pragma unroll
                    for (int n = 0; n < 2; ++n) acc[a][b][m][n] = (f32x4){0.f, 0.f, 0.f, 0.f};
        cur = nxt; cA = nA; cB = nB; ++ui;
        if constexpr (ALIGN_EPI) { if (wr == 1) PG8_BAR; }
    }
    PG8_WAIT_V(0);
    if constexpr (!ALIGN_EPI) { if (wr == 0) PG8_BAR; }
    PG8_BAR;
    if constexpr (Epi::AFTER_DRAIN) { E.fused(acc, cur, wr, wc, fr, fq, lds, wid, lane); S.done(cur); }
#undef PG8_SA
#undef PG8_SB
#undef PG8_STAGE
#undef PG8_LDA
#undef PG8_LDB
#undef PG8_MMA
#undef PG8_WAIT_V
#undef PG8_WAIT_L
#undef PG8_BAR
#undef PG8_SCHED
}
}

#define GAS __attribute__((address_space(1)))
#define LAS __attribute__((address_space(3)))
typedef unsigned short bf16;
typedef unsigned v4u __attribute__((ext_vector_type(4)));
typedef unsigned v2u __attribute__((ext_vector_type(2)));
typedef float f32x4 __attribute__((ext_vector_type(4)));
typedef float f32x16 __attribute__((ext_vector_type(16)));
typedef short bf16x8 __attribute__((ext_vector_type(8)));
typedef short s16x4 __attribute__((ext_vector_type(4)));
typedef GAS unsigned gu32;
#define RLX_AGENT __ATOMIC_RELAXED, __HIP_MEMORY_SCOPE_AGENT
#define LDS_WAIT() asm volatile("s_waitcnt lgkmcnt(0)" ::: "memory")
#define VM_WAIT() asm volatile("s_waitcnt vmcnt(0)" ::: "memory")
__device__ __forceinline__ unsigned f2bf(float f) { unsigned u = __builtin_bit_cast(unsigned, f); return (u + 0x7fffu + ((u >> 16) & 1u)) >> 16; }
__device__ __forceinline__ unsigned pk2(float lo, float hi) { return f2bf(lo) | (f2bf(hi) << 16); }
__device__ __forceinline__ float bf2f(unsigned b) { return __builtin_bit_cast(float, b << 16); }
__device__ __forceinline__ float bflo(unsigned w) { return __builtin_bit_cast(float, w << 16); }
__device__ __forceinline__ float bfhi(unsigned w) { return __builtin_bit_cast(float, w & 0xffff0000u); }
__device__ __forceinline__ float wave_sum(float v) {
#pragma unroll
    for (int o = 1; o < 64; o <<= 1) v += __shfl_xor(v, o);
    return v;
}
__device__ __forceinline__ float wave_max(float v) {
#pragma unroll
    for (int o = 1; o < 64; o <<= 1) v = fmaxf(v, __shfl_xor(v, o));
    return v;
}

#define XB_TMO      128
#define XB_XCNT(j)  (256  + 64 * (j))
#define XB_XSUB(j)  (1280 + 64 * (j))
#define XB_XGEN(j)  (2304 + 64 * (j))
#define XB_TOP      3328
#define XB_TOPGEN   3392
#define XCD_BAR_WORDS 3456
#define XB_SPIN_CAP (1u << 18)

__device__ __forceinline__ unsigned xb_ld(unsigned* p)              { return __hip_atomic_load(p, __ATOMIC_RELAXED, __HIP_MEMORY_SCOPE_AGENT); }
__device__ __forceinline__ unsigned xb_add(unsigned* p, unsigned v) { return __hip_atomic_fetch_add(p, v, __ATOMIC_RELAXED, __HIP_MEMORY_SCOPE_AGENT); }
__device__ __forceinline__ unsigned xb_xcc_id() { return (unsigned)__builtin_amdgcn_s_getreg((3 << 11) | 20) & 0xFu; }
#define XB_SPIN(cond, bar) do { unsigned _sp = 0; while (cond) { __builtin_amdgcn_s_sleep(1); \
    if ((++_sp & 255u) == 0u) { if (xb_ld(&(bar)[XB_TMO])) break; if (_sp > XB_SPIN_CAP) { atomicAdd(&(bar)[XB_TMO], 1u); break; } } } } while (0)

struct XcdBarrier {
    unsigned* bar; unsigned x;
    volatile LAS unsigned* st;
};

__device__ __forceinline__ XcdBarrier xcd_barrier_post(unsigned* bar, volatile LAS unsigned* st) {
    XcdBarrier b; b.bar = bar; b.x = xb_xcc_id(); b.st = st;
    if (threadIdx.x == 0) (void)xb_add(&bar[XB_XCNT(b.x)], 1u);
    return b;
}
__device__ __forceinline__ void xcd_barrier_complete(unsigned* bar, unsigned x, unsigned& nloc, unsigned& nx) {
    const unsigned G = gridDim.x * gridDim.y * gridDim.z;
    unsigned sum, cnt, mine, sp = 0u;
    for (;;) {
        sum = 0u; cnt = 0u; mine = 0u;
#pragma unroll
        for (unsigned j = 0; j < 16; ++j) { const unsigned c = xb_ld(&bar[XB_XCNT(j)]); sum += c; cnt += (c > 0u) ? 1u : 0u; mine = (j == x) ? c : mine; }
        if (sum == G) break;
        __builtin_amdgcn_s_sleep(1);
        if ((++sp & 255u) == 0u) { if (xb_ld(&bar[XB_TMO])) break; if (sp > XB_SPIN_CAP) { atomicAdd(&bar[XB_TMO], 1u); break; } }
    }
    nloc = mine > 0u ? mine : 1u; nx = cnt > 0u ? cnt : 1u;
}

__device__ __forceinline__ void xcd_barrier(const XcdBarrier& b) {
    asm volatile("s_waitcnt vmcnt(0)" ::: "memory");
    __syncthreads();
    if (threadIdx.x == 0) {
        unsigned* bar = b.bar;
        __builtin_amdgcn_s_waitcnt(0);
        unsigned nloc = b.st[0], nx = b.st[1];
        if (nloc == 0u) { xcd_barrier_complete(bar, b.x, nloc, nx); b.st[0] = nloc; b.st[1] = nx; }
        const unsigned old = xb_add(&bar[XB_XSUB(b.x)], 1u);
        const unsigned gen = old / nloc;
        if (old + 1u == (gen + 1u) * nloc) {
            __builtin_amdgcn_fence(__ATOMIC_RELEASE, "agent");
            asm volatile("s_waitcnt vmcnt(0)" ::: "memory");
            const unsigned og = xb_add(&bar[XB_TOP], 1u);
            const unsigned tg = og / nx;
            if (og + 1u == (tg + 1u) * nx) xb_add(&bar[XB_TOPGEN], 1u);
            else XB_SPIN(xb_ld(&bar[XB_TOPGEN]) == tg, bar);
            __builtin_amdgcn_fence(__ATOMIC_ACQUIRE, "agent");
            xb_add(&bar[XB_XGEN(b.x)], 1u);
            asm volatile("s_waitcnt vmcnt(0)" ::: "memory");
        } else {
            XB_SPIN(xb_ld(&bar[XB_XGEN(b.x)]) == gen, bar);
            __builtin_amdgcn_fence(__ATOMIC_ACQUIRE, "agent");
            asm volatile("s_waitcnt vmcnt(0)" ::: "memory");
        }
    }
    __syncthreads();
}

#ifndef NAIVE_CMP
#define NAIVE_CMP 0
#endif
#ifndef NAIVE_ATTN
#define NAIVE_ATTN 0
#endif
#ifndef NAIVE_HGRN
#define NAIVE_HGRN 0
#endif
#ifndef NAIVE_MOE
#define NAIVE_MOE 0
#endif
#ifndef ATT_PARTS
#define ATT_PARTS 7
#endif
#ifndef MK_ONE_LAUNCH
#define MK_ONE_LAUNCH 1
#endif
#ifndef DUP
#define DUP -1
#endif
#ifndef PHMASK
#define PHMASK 0xFFFF
#endif

constexpr int NWAVES = 8;
constexpr int NTOK = 16384, SEQ = 4096, DM = 2048;
constexpr int LDP = 6912;
constexpr int C_HQ = 0, C_HF = 1024, C_HI = 2048, C_HG = 3072, C_NQ = 4096, C_KC = 5120, C_VC = 5376, C_KS = 5632, C_VS = 5888, C_KW = 6144, C_VW = 6400, C_GR = 6656, IN_COLS = 6704;
constexpr float EPS = 1e-6f;
constexpr int MAXSLOT = 40960;
constexpr int MAXTILE = MAXSLOT / 256;

constexpr size_t MiB = 1u << 20;
constexpr size_t WS_CTL = 0, CTL_ZERO_BYTES = 1 * MiB;
constexpr size_t WS_SM = 1 * MiB;
constexpr size_t SM_LB = WS_SM + 0, SM_B1K = WS_SM + 4096, SM_B1V = WS_SM + 8192, SM_W2KT = WS_SM + 16384, SM_W2VT = WS_SM + 49152;
constexpr size_t SM_COS = WS_SM + 128 * 1024, SM_SIN = SM_COS + 512 * 1024;
constexpr size_t SM_W1KT = WS_SM + 2 * MiB, SM_W1VT = WS_SM + 3 * MiB;
constexpr size_t SM_EID = WS_SM + 5 * MiB, SM_EW = SM_EID + 128 * 1024, SM_TSLOT = SM_EW + 128 * 1024, SM_STOK = SM_TSLOT + 128 * 1024, SM_SW = SM_STOK + 160 * 1024, SM_TILEE = SM_SW + 160 * 1024;
constexpr size_t SM_RTH = WS_SM + 4 * MiB, SM_RTL = SM_RTH + 256 * 1024, SM_RSTD = SM_RTL + 256 * 1024, SM_SRS = SM_RSTD + 128 * 1024;
constexpr size_t SM_BPART = SM_SRS + 192 * 1024;
constexpr size_t WS_HIDC = WS_SM + 6 * MiB;
constexpr size_t WS_KC = 11 * MiB, WS_VC = 11 * MiB + 512 * 1024;
constexpr size_t WS_WINT = 12 * MiB;
constexpr size_t WS_WOT = 39 * MiB;
constexpr size_t WS_B = 47 * MiB;
constexpr size_t WS_PROJ = 111 * MiB;
constexpr size_t WS_WGUT = WS_PROJ, WS_HIDM = WS_PROJ + 128 * MiB;
constexpr size_t WS_D = 328 * MiB;
constexpr size_t WS_OI = WS_D, WS_U = WS_D + 32 * MiB, WS_DD = WS_D + 96 * MiB, WS_ONSA = WS_D + 97 * MiB;
constexpr size_t WS_SP = WS_D + 161 * MiB;
constexpr size_t WS_WDT = WS_D, WS_XG = WS_D + 64 * MiB;
constexpr size_t WS_END = WS_D + 226 * MiB;
static_assert(WS_END <= 584 * MiB, "workspace map");
constexpr int CW_TMO = 0, CW_CODE = 1, CW_BAR = 4096, CW_CNT = 8192, CW_CUR = 8192 + 64, CW_HQ = 8192 + 128, CW_NT = 8192 + 192, CW_TMAP = 12288;

constexpr int RING_OFF = 0, RING_BYTES = 131072;
constexpr int LDSCTL_OFF = RING_BYTES, MISC_OFF = LDSCTL_OFF + 320;
constexpr int LDS_BYTES = 147456;

struct Frame {
    LAS unsigned char* lds;
    volatile LAS unsigned* MISC;
    gu32* ctl;
    int tid, lane, wave, vcu, G;
    const float* in[22]; float* out; unsigned char* ws;
};
#define IN_X 0
#define IN_ATTN_NORM 1
#define IN_W_IN 2
#define IN_LB 3
#define IN_HG_NORM 4
#define IN_POS_K 5
#define IN_W1_K 6
#define IN_W2_K 7
#define IN_POS_V 8
#define IN_W1_V 9
#define IN_W2_V 10
#define IN_NSA_NORM 11
#define IN_W_OUT 12
#define IN_FFN_NORM 13
#define IN_W_GROUP 14
#define IN_B_GROUP 15
#define IN_W_ROUTER 16
#define IN_B_ROUTER 17
#define IN_W_GATE 18
#define IN_W_UP 19
#define IN_W_DOWN 20
#define IN_FINAL_NORM 21

__device__ __forceinline__ void transpose_item(const float* W, int ldn, int Nvalid, bf16* WT, int Kd, LAS float* scr, int k0, int n0, int lane, int ilv = -1) {
    f32x4 v[8]; const int nq = (lane & 7) * 4;
#pragma unroll
    for (int i = 0; i < 8; ++i) { const int kk = 8 * i + (lane >> 3); v[i] = (n0 + nq < Nvalid) ? *(const f32x4*)(W + (size_t)(k0 + kk) * ldn + n0 + nq) : (f32x4){0.f, 0.f, 0.f, 0.f}; }
#pragma unroll
    for (int i = 0; i < 8; ++i) { LAS float* s = scr + (8 * i + (lane >> 3)) * 33 + nq; s[0] = v[i].x; s[1] = v[i].y; s[2] = v[i].z; s[3] = v[i].w; }
    LDS_WAIT();
    const int c = lane & 7;
#pragma unroll
    for (int j = 0; j < 4; ++j) { const int n = (lane >> 3) + 8 * j; const LAS float* s = scr + (8 * c) * 33 + n;
        v4u o; o.x = pk2(s[0 * 33], s[1 * 33]); o.y = pk2(s[2 * 33], s[3 * 33]); o.z = pk2(s[4 * 33], s[5 * 33]); o.w = pk2(s[6 * 33], s[7 * 33]);
        const int nn = n0 + n; const int drow = (ilv < 0) ? nn : (8 * (nn >> 2) + (nn & 3) + ilv);
        *(v4u*)(WT + (size_t)drow * Kd + k0 + 8 * c) = o; }
    LDS_WAIT();
}
__device__ __forceinline__ void rms_row_to_bf16(const float* xrow, const float* gain, bf16* orow, int lane) {
    const f32x4* xr = (const f32x4*)xrow + lane; const f32x4* gr = (const f32x4*)gain + lane;
    f32x4 v[8]; float s = 0.f;
#pragma unroll
    for (int j = 0; j < 8; ++j) { v[j] = xr[64 * j]; s += (v[j].x * v[j].x + v[j].y * v[j].y) + (v[j].z * v[j].z + v[j].w * v[j].w); }
    const float rstd = 1.0f / sqrtf(wave_sum(s) * (1.f / DM) + EPS);
    unsigned long long* o8 = (unsigned long long*)orow + lane;
#pragma unroll
    for (int j = 0; j < 8; ++j) { const f32x4 g = gr[64 * j]; o8[64 * j] = (unsigned long long)pk2(v[j].x * rstd * g.x, v[j].y * rstd * g.y) | ((unsigned long long)pk2(v[j].z * rstd * g.z, v[j].w * rstd * g.w) << 32); }
}
__device__ __forceinline__ void p0_prologue(Frame& F) {
    LAS float* scr = (LAS float*)(F.lds + RING_OFF + F.wave * 16384);
    const int gw = F.vcu * NWAVES + F.wave, NGW = F.G * NWAVES;
    constexpr int I_IN = 32 * (LDP / 32), I_O = 32 * 64, I_W1 = 32 * 8, I_W2 = 4 * 2;
    constexpr int NITEMS = I_IN + I_O + 2 * I_W1 + 2 * I_W2;
    for (int it = gw; it < NITEMS; it += NGW) {
        int r = it;
        if (r < I_IN) { const int nblk = LDP / 32; transpose_item(F.in[IN_W_IN], IN_COLS, IN_COLS, (bf16*)(F.ws + WS_WINT), DM, scr, 64 * (r / nblk), 32 * (r % nblk), F.lane); continue; } r -= I_IN;
        if (r < I_O) { transpose_item(F.in[IN_W_OUT], DM, DM, (bf16*)(F.ws + WS_WOT), DM, scr, 64 * (r / 64), 32 * (r % 64), F.lane); continue; } r -= I_O;
        if (r < I_W1) { transpose_item(F.in[IN_W1_K], 256, 256, (bf16*)(F.ws + SM_W1KT), 2048, scr, 64 * (r / 8), 32 * (r % 8), F.lane); continue; } r -= I_W1;
        if (r < I_W1) { transpose_item(F.in[IN_W1_V], 256, 256, (bf16*)(F.ws + SM_W1VT), 2048, scr, 64 * (r / 8), 32 * (r % 8), F.lane); continue; } r -= I_W1;
        if (r < I_W2) { transpose_item(F.in[IN_W2_K], 64, 64, (bf16*)(F.ws + SM_W2KT), 256, scr, 64 * (r / 2), 32 * (r % 2), F.lane); continue; } r -= I_W2;
        transpose_item(F.in[IN_W2_V], 64, 64, (bf16*)(F.ws + SM_W2VT), 256, scr, 64 * (r / 2), 32 * (r % 2), F.lane);
    }
    bf16* H = (bf16*)(F.ws + WS_B);
    for (int m = gw; m < NTOK; m += NGW) rms_row_to_bf16(F.in[IN_X] + (size_t)m * DM, F.in[IN_ATTN_NORM], H + (size_t)m * DM, F.lane);
    const int gt = F.vcu * (NWAVES * 64) + F.tid, NT = F.G * NWAVES * 64;
    float* LB = (float*)(F.ws + SM_LB);
    for (int i = gt; i < 1024; i += NT) { const float a0 = F.in[IN_LB][i], a1 = F.in[IN_LB][1024 + i]; LB[i] = 1.0f / (1.0f + expf(a1 - a0)); }
    float* COS = (float*)(F.ws + SM_COS); float* SIN = (float*)(F.ws + SM_SIN);
    for (int i = gt; i < SEQ * 32; i += NT) { const int t = i >> 5, k = i & 31;
        const double inv = exp2(-(double)k * (13.287712379549449 / 32.0));
        double rev = (double)t * inv * 0.15915494309189535; rev -= rint(rev);
        COS[i] = __builtin_amdgcn_cosf((float)rev); SIN[i] = __builtin_amdgcn_sinf((float)rev); }
    {   float* BP = (float*)(F.ws + SM_BPART);
        for (int it = gw; it < 256; it += NGW) { const int br = it >> 7, ch = (it >> 2) & 31, j = (it & 3) * 64 + F.lane; const float* pos = F.in[br ? IN_POS_V : IN_POS_K] + ch * 64; const float* w1 = F.in[br ? IN_W1_V : IN_W1_K] + (size_t)(ch * 64) * 256 + j;
            float a[8];
#pragma unroll
            for (int u = 0; u < 8; ++u) a[u] = 0.f;
#pragma unroll
            for (int k = 0; k < 64; k += 8) {
#pragma unroll
                for (int u = 0; u < 8; ++u) a[u] += pos[k + u] * w1[(size_t)(k + u) * 256]; }
            BP[(br * 32 + ch) * 256 + j] = ((a[0] + a[1]) + (a[2] + a[3])) + ((a[4] + a[5]) + (a[6] + a[7])); } }
    {   bf16* RTH = (bf16*)(F.ws + SM_RTH); bf16* RTL = (bf16*)(F.ws + SM_RTL);
        for (int i = gt; i < 48 * DM; i += NT) { const int j = i >> 11, dd = i & (DM - 1);
            float wv = 0.f; if (j < 4) wv = F.in[IN_W_GROUP][dd * 4 + j]; else if (j < 36) wv = F.in[IN_W_ROUTER][dd * 32 + (j - 4)];
            wv *= F.in[IN_FFN_NORM][dd]; const unsigned hi = f2bf(wv); RTH[i] = (bf16)hi; RTL[i] = (bf16)f2bf(wv - bf2f(hi)); } }
    unsigned* pad = (unsigned*)((bf16*)(F.ws + WS_PROJ) + (size_t)NTOK * LDP);
    for (int i = gt; i < 16 * LDP / 2; i += NT) pad[i] = 0u;
}

__device__ __forceinline__ void n2_rope_compress(Frame& F) {
    bf16* PROJ = (bf16*)(F.ws + WS_PROJ);
    const float* COS = (const float*)(F.ws + SM_COS); const float* SIN = (const float*)(F.ws + SM_SIN);
    const int gt = F.vcu * (NWAVES * 64) + F.tid, NT = F.G * NWAVES * 64;
    for (int idx = gt; idx < NTOK * 256; idx += NT) { const int i = idx & 31, g = (idx >> 5) & 3, ten = (idx >> 7) & 1, tok = idx >> 8, pos = tok & (SEQ - 1);
        bf16* p = PROJ + (size_t)tok * LDP + (ten ? C_KW : C_KS) + g * 64 + i;
        const float a = bf2f(p[0]), b = bf2f(p[32]), c = COS[pos * 32 + i], s = SIN[pos * 32 + i];
        p[0] = (bf16)f2bf(a * c - b * s); p[32] = (bf16)f2bf(b * c + a * s); }
#if NAIVE_CMP
    LAS float* scr = (LAS float*)(F.lds + RING_OFF + F.wave * 16384);
    const int gw = F.vcu * NWAVES + F.wave, NGW = F.G * NWAVES;
    for (int it = gw; it < 2 * 4080; it += NGW) {
        const int br = it / 4080; int r = it % 4080; const int b = r / 1020; r %= 1020; const int c = r >> 2, g = r & 3;
        const float* pos = F.in[br ? IN_POS_V : IN_POS_K]; const float* w1 = F.in[br ? IN_W1_V : IN_W1_K]; const float* w2 = F.in[br ? IN_W2_V : IN_W2_K];
        const bf16* src = PROJ + (size_t)(b * SEQ + c * 16) * LDP + (br ? C_VC : C_KC) + g * 64;
        for (int k = F.lane; k < 2048; k += 64) scr[k] = bf2f(src[(size_t)(k >> 6) * LDP + (k & 63)]) + pos[k];
        LDS_WAIT();
        float a0 = 0.f, a1 = 0.f, a2 = 0.f, a3 = 0.f;
        for (int k = 0; k < 2048; ++k) { const float f = scr[k]; const float* w = w1 + (size_t)k * 256 + F.lane; a0 += f * w[0]; a1 += f * w[64]; a2 += f * w[128]; a3 += f * w[192]; }
        scr[2048 + F.lane] = pg8::gelu_tanh(a0); scr[2048 + 64 + F.lane] = pg8::gelu_tanh(a1); scr[2048 + 128 + F.lane] = pg8::gelu_tanh(a2); scr[2048 + 192 + F.lane] = pg8::gelu_tanh(a3);
        LDS_WAIT();
        float o = 0.f;
        for (int j = 0; j < 256; ++j) o += scr[2048 + j] * w2[j * 64 + F.lane];
        ((bf16*)(F.ws + (br ? WS_VC : WS_KC)))[((size_t)(b * 256 + c) * 4 + g) * 64 + F.lane] = (bf16)f2bf(o);
        LDS_WAIT();
    }
#endif
}

__device__ __forceinline__ void n3_hgrn(Frame& F, int bh) {
    const int b = bh >> 3, h = bh & 7;
    const bf16* PROJ = (const bf16*)(F.ws + WS_PROJ); bf16* Y = (bf16*)(F.ws + WS_B);
    const float* LB = (const float*)(F.ws + SM_LB); const float* gain = F.in[IN_HG_NORM];
    LAS float* qs = (LAS float*)(F.lds); LAS float* fs = qs + 2048; LAS float* is = fs + 2048; LAS float* po = is + 2048;
    const int v = F.tid & 127, kq = F.tid >> 7;
    float S[32];
#pragma unroll
    for (int i = 0; i < 32; ++i) S[i] = 0.f;
    for (int blk = 0; blk < SEQ / 16; ++blk) {
        const int t0 = blk * 16;
        for (int e = F.tid; e < 2048; e += 512) { const int s = e >> 7, k = e & 127; const bf16* row = PROJ + (size_t)(b * SEQ + t0 + s) * LDP + h * 128 + k;
            const float lb = LB[h * 128 + k];
            qs[e] = bf2f(row[C_HQ]) * 0.08838834764831845f;
            fs[e] = lb + (1.0f - lb) / (1.0f + __expf(-bf2f(row[C_HF])));
            is[e] = bf2f(row[C_HI]); }
        __syncthreads();
        for (int s = 0; s < 16; ++s) { const float vv = is[s * 128 + v]; float acc = 0.f;
#pragma unroll
            for (int i = 0; i < 32; ++i) { const float f = fs[s * 128 + kq * 32 + i], q = qs[s * 128 + kq * 32 + i]; S[i] = f * S[i] + (1.0f - f) * vv; acc += q * S[i]; }
            po[(s * 4 + kq) * 128 + v] = acc; }
        __syncthreads();
#pragma unroll
        for (int ss = 0; ss < 2; ++ss) { const int s = F.wave * 2 + ss; const int tok = b * SEQ + t0 + s;
            const float o0 = (po[(s * 4 + 0) * 128 + F.lane] + po[(s * 4 + 1) * 128 + F.lane]) + (po[(s * 4 + 2) * 128 + F.lane] + po[(s * 4 + 3) * 128 + F.lane]);
            const float o1 = (po[(s * 4 + 0) * 128 + 64 + F.lane] + po[(s * 4 + 1) * 128 + 64 + F.lane]) + (po[(s * 4 + 2) * 128 + 64 + F.lane] + po[(s * 4 + 3) * 128 + 64 + F.lane]);
            const float rstd = 1.0f / sqrtf(wave_sum(o0 * o0 + o1 * o1) * (1.f / 128.f) + EPS);
            const bf16* grow = PROJ + (size_t)tok * LDP + C_HG + h * 128;
            const float g0 = bf2f(grow[F.lane]), g1 = bf2f(grow[64 + F.lane]);
            Y[(size_t)tok * DM + h * 128 + F.lane] = (bf16)f2bf(o0 * rstd * gain[F.lane] * (g0 / (1.0f + __expf(-g0))));
            Y[(size_t)tok * DM + h * 128 + 64 + F.lane] = (bf16)f2bf(o1 * rstd * gain[64 + F.lane] * (g1 / (1.0f + __expf(-g1)))); }
        __syncthreads();
    }
}
__device__ __forceinline__ float dot64(const LAS float* q, const bf16* krow) {
    const v4u* kr = (const v4u*)krow; float s = 0.f;
#pragma unroll
    for (int j = 0; j < 8; ++j) { const v4u w = kr[j]; const LAS float* qq = q + 8 * j;
        s += qq[0] * bflo(w.x) + qq[1] * bfhi(w.x) + qq[2] * bflo(w.y) + qq[3] * bfhi(w.y) + qq[4] * bflo(w.z) + qq[5] * bfhi(w.z) + qq[6] * bflo(w.w) + qq[7] * bfhi(w.w); }
    return s;
}
__device__ __forceinline__ void n3_attn_item(Frame& F, int item, LAS float* scr) {
    const bf16* PROJ = (const bf16*)(F.ws + WS_PROJ);
    const bf16* KC = (const bf16*)(F.ws + WS_KC); const bf16* VC = (const bf16*)(F.ws + WS_VC);
    const float* COS = (const float*)(F.ws + SM_COS); const float* SIN = (const float*)(F.ws + SM_SIN);
    float* ONSA = (float*)(F.ws + WS_ONSA);
    const int lane = F.lane;
    const int g = item & 3, tok = item >> 2, b = tok >> 12, t = tok & (SEQ - 1), cur = t >> 6;
    LAS float* qf = scr; LAS float* qr = scr + 256; LAS float* ps = scr + 512; LAS float* pc = scr + 768; LAS float* pb = scr + 1024;
    const bf16* qrow = PROJ + (size_t)tok * LDP + C_NQ + g * 256;
#pragma unroll
    for (int r = 0; r < 4; ++r) { const float q = bf2f(qrow[r * 64 + lane]); qf[r * 64 + lane] = q;
        const float qp = bf2f(qrow[r * 64 + (lane ^ 32)]); const float c = COS[t * 32 + (lane & 31)], s = SIN[t * 32 + (lane & 31)];
        qr[r * 64 + lane] = (lane < 32) ? (q * c - qp * s) : (q * c + qp * s); }
#pragma unroll
    for (int i = 0; i < 4; ++i) ps[i * 64 + lane] = 0.f;
    LDS_WAIT();
    const int nvalid = (t >= 31) ? ((t - 31) >> 4) + 1 : 0;
    float oc[4];
#pragma unroll
    for (int r = 0; r < 4; ++r) {
        float s[4]; float m = -3.0e38f;
#pragma unroll
        for (int i = 0; i < 4; ++i) { const int c = lane + 64 * i; s[i] = (c < nvalid) ? dot64(qf + r * 64, KC + ((size_t)(b * 256 + c) * 4 + g) * 64) * 0.125f : -3.0e38f; m = fmaxf(m, s[i]); }
        m = wave_max(m); float e[4]; float sum = 0.f;
#pragma unroll
        for (int i = 0; i < 4; ++i) { const int c = lane + 64 * i; e[i] = (c < nvalid) ? __expf(s[i] - m) : 0.f; sum += e[i]; }
        sum = wave_sum(sum); const float inv = (nvalid > 0) ? 1.0f / sum : 0.f;
#pragma unroll
        for (int i = 0; i < 4; ++i) { const float p = e[i] * inv; pc[i * 64 + lane] = p; ps[i * 64 + lane] += p; }
        LDS_WAIT();
        float a = 0.f;
        for (int c = 0; c < nvalid; ++c) a += pc[c] * bf2f(VC[((size_t)(b * 256 + c) * 4 + g) * 64 + lane]);
        oc[r] = a;
        LDS_WAIT();
    }
    float imp = 0.f;
#pragma unroll
    for (int dc = -1; dc <= 3; ++dc) { const int c = 4 * lane + dc; if (c >= 0 && c <= 254) imp += ps[c]; }
    const bool forced = (lane == 0) || (lane == cur) || (lane == cur - 1);
    const bool causal = lane <= cur;
    const float val = forced ? 1.0e9f : (causal ? imp : -1.0e9f);
    int rank = 0;
    for (int i = 0; i < 64; ++i) { const float vi = __shfl(val, i); rank += (vi > val || (vi == val && i < lane)) ? 1 : 0; }
    const unsigned long long selmask = __ballot((rank < 16) && causal);
    const bf16* gr = PROJ + (size_t)tok * LDP + C_GR + g * 12;
#pragma unroll
    for (int r = 0; r < 4; ++r) {
        float m = -3.0e38f, l = 0.f, acc = 0.f;
        unsigned long long mk = selmask;
        while (mk) { const int jb = __builtin_ctzll(mk); mk &= mk - 1;
            const int pos = jb * 64 + lane; const bool valid = pos <= t;
            const float s = valid ? dot64(qr + r * 64, PROJ + (size_t)(b * SEQ + pos) * LDP + C_KS + g * 64) * 0.125f : -3.0e38f;
            const float mn = fmaxf(m, wave_max(s)); const float alpha = __expf(m - mn); const float p = valid ? __expf(s - mn) : 0.f;
            l = l * alpha + wave_sum(p); acc *= alpha; pb[lane] = p; LDS_WAIT();
            const bf16* vb = PROJ + (size_t)(b * SEQ + jb * 64) * LDP + C_VS + g * 64 + lane;
            for (int k = 0; k < 64; ++k) acc += pb[k] * bf2f(vb[(size_t)k * LDP]);
            m = mn; LDS_WAIT(); }
        const float os = acc / l;
        m = -3.0e38f; l = 0.f; acc = 0.f;
        for (int i = 0; i < 8; ++i) { const int base = t - 511 + 64 * i; if (base + 63 < 0) continue;
            const int pos = base + lane; const bool valid = pos >= 0;
            const float s = valid ? dot64(qr + r * 64, PROJ + (size_t)(b * SEQ + pos) * LDP + C_KW + g * 64) * 0.125f : -3.0e38f;
            const float mn = fmaxf(m, wave_max(s)); const float alpha = __expf(m - mn); const float p = valid ? __expf(s - mn) : 0.f;
            l = l * alpha + wave_sum(p); acc *= alpha; pb[lane] = p; LDS_WAIT();
            const int k0 = base < 0 ? -base : 0;
            const bf16* vb = PROJ + (size_t)(b * SEQ) * LDP + C_VW + g * 64 + lane;
            for (int k = k0; k < 64; ++k) acc += pb[k] * bf2f(vb[(size_t)(base + k) * LDP]);
            m = mn; LDS_WAIT(); }
        const float ow = acc / l;
        const float gc = 1.0f / (1.0f + __expf(-bf2f(gr[r * 3 + 0]))), gs = 1.0f / (1.0f + __expf(-bf2f(gr[r * 3 + 1]))), gw = 1.0f / (1.0f + __expf(-bf2f(gr[r * 3 + 2])));
        ONSA[(size_t)tok * 1024 + (g * 4 + r) * 64 + lane] = gc * oc[r] + gs * os + gw * ow;
    }
}
__device__ __forceinline__ void n3_mixers(Frame& F) {
#if NAIVE_HGRN
    if (F.vcu < 32) n3_hgrn(F, F.vcu);
#endif
    LAS float* scr = (LAS float*)(F.lds + RING_OFF + F.wave * 16384);
    const int gw = F.vcu * NWAVES + F.wave, NGW = F.G * NWAVES;
    for (int it = gw; it < NTOK * 4; it += NGW) n3_attn_item(F, it, scr);
}
constexpr int PH = 272;
constexpr int IMG_Q = 0, IMG_K = 64 * PH, IMG_KH = 2 * 64 * PH, IMG_V = 3 * 64 * PH, HG_SEG = 4 * 64 * PH;
__device__ __forceinline__ unsigned pkc(float a, float b) { typedef __bf16 bf2 __attribute__((ext_vector_type(2))); typedef float f2 __attribute__((ext_vector_type(2))); f2 v = {a, b}; bf2 r = __builtin_convertvector(v, bf2); return __builtin_bit_cast(unsigned, r); }
__device__ __forceinline__ bf16x8 pack8(const f32x16& x, int s) { v4u p;
    if (s == 0) { p.x = pkc(x[0], x[1]); p.y = pkc(x[2], x[3]); p.z = pkc(x[4], x[5]); p.w = pkc(x[6], x[7]); }
    else { p.x = pkc(x[8], x[9]); p.y = pkc(x[10], x[11]); p.z = pkc(x[12], x[13]); p.w = pkc(x[14], x[15]); }
    return __builtin_bit_cast(bf16x8, p); }
__device__ __forceinline__ f32x16 mfma32(bf16x8 a, bf16x8 b, f32x16 c) { return __builtin_amdgcn_mfma_f32_32x32x16_bf16(a, b, c, 0, 0, 0); }
__device__ __forceinline__ bf16x8 tr_frag(unsigned a0, unsigned a1) { s16x4 lo, hi;
    asm volatile("ds_read_b64_tr_b16 %0, %2\n\tds_read_b64_tr_b16 %1, %3\n\ts_waitcnt lgkmcnt(0)" : "=&v"(lo), "=&v"(hi) : "v"(a0), "v"(a1) : "memory");
    return __builtin_shufflevector(lo, hi, 0, 1, 2, 3, 4, 5, 6, 7); }
__device__ __forceinline__ f32x16 zero16() { f32x16 z;
#pragma unroll
    for (int i = 0; i < 16; ++i) z[i] = 0.f; return z; }

__device__ __forceinline__ void tr_read8(unsigned a0, unsigned a1, unsigned a2, unsigned a3, unsigned a4, unsigned a5, unsigned a6, unsigned a7, bf16x8& f0, bf16x8& f1, bf16x8& f2, bf16x8& f3) {
    s16x4 x0, x1, x2, x3, x4, x5, x6, x7;
    asm volatile("ds_read_b64_tr_b16 %0, %8\n\tds_read_b64_tr_b16 %1, %9\n\tds_read_b64_tr_b16 %2, %10\n\tds_read_b64_tr_b16 %3, %11\n\t"
                 "ds_read_b64_tr_b16 %4, %12\n\tds_read_b64_tr_b16 %5, %13\n\tds_read_b64_tr_b16 %6, %14\n\tds_read_b64_tr_b16 %7, %15\n\ts_waitcnt lgkmcnt(0)"
                 : "=&v"(x0), "=&v"(x1), "=&v"(x2), "=&v"(x3), "=&v"(x4), "=&v"(x5), "=&v"(x6), "=&v"(x7)
                 : "v"(a0), "v"(a1), "v"(a2), "v"(a3), "v"(a4), "v"(a5), "v"(a6), "v"(a7) : "memory");
    f0 = __builtin_shufflevector(x0, x1, 0, 1, 2, 3, 4, 5, 6, 7); f1 = __builtin_shufflevector(x2, x3, 0, 1, 2, 3, 4, 5, 6, 7);
    f2 = __builtin_shufflevector(x4, x5, 0, 1, 2, 3, 4, 5, 6, 7); f3 = __builtin_shufflevector(x6, x7, 0, 1, 2, 3, 4, 5, 6, 7);
}
template <bool STORE> __device__ __forceinline__ void hgrn_passA(Frame& F) {
    bf16* PROJ = (bf16*)(F.ws + WS_PROJ); bf16* OI = (bf16*)(F.ws + WS_OI); bf16* U = (bf16*)(F.ws + WS_U); float* DD = (float*)(F.ws + WS_DD);
    const float* LB = (const float*)(F.ws + SM_LB);
    LAS unsigned char* L = F.lds; const unsigned lbase = (unsigned)(size_t)L;
    const int lane = F.lane, r = lane & 31, h = lane >> 5;
    const unsigned trl = (unsigned)(((lane & 15) >> 2) * PH + (16 * ((lane >> 4) & 1) + 4 * (lane & 3)) * 2);
    const int k = F.tid & 127, seg = F.tid >> 7;
    LAS int* qslot = (LAS int*)(L + HG_SEG + 2048);
    gu32* qctr = F.ctl + (STORE ? CW_HQ : CW_HQ + 1);
    if (F.tid == 0) *qslot = (int)__hip_atomic_fetch_add(qctr, 1u, RLX_AGENT);
    __syncthreads();
    int unit = *qslot;
    __syncthreads();
    unsigned short fw[16], qw[16], iw[16];
    if (unit < 2048) { const bf16* cp0 = PROJ + (size_t)((unit >> 9) * SEQ + (unit & 63) * 64 + seg * 16) * LDP + ((unit >> 6) & 7) * 128 + k;
#pragma unroll
        for (int i = 0; i < 16; ++i) { fw[i] = cp0[(size_t)i * LDP + C_HF]; qw[i] = cp0[(size_t)i * LDP + C_HQ]; iw[i] = cp0[(size_t)i * LDP + C_HI]; } }
    while (unit < 2048) {
        const int hh = (unit >> 6) & 7, c = unit & 63, tok0 = (unit >> 9) * SEQ + c * 64;
        if (F.tid == 0) *qslot = (int)__hip_atomic_fetch_add(qctr, 1u, RLX_AGENT);
        const float lb = LB[hh * 128 + k];
        float cs[16], kf[16]; float run = 0.f;
        bf16* colp = PROJ + (size_t)(tok0 + seg * 16) * LDP + hh * 128 + k;
#pragma unroll
        for (int i = 0; i < 16; ++i) { const float fr = bf2f(fw[i]); const float f = lb + (1.0f - lb) / (1.0f + __expf(-fr)); run += __logf(f); cs[i] = run; kf[i] = 1.0f - f; }
        LAS float* segtot = (LAS float*)(L + HG_SEG);
        segtot[seg * 128 + k] = run;
        __syncthreads();
        const int next = *qslot;
        const float t0 = segtot[k], t1 = segtot[128 + k], t2 = segtot[256 + k], t3 = segtot[384 + k];
        const float off = (seg > 0 ? t0 : 0.f) + (seg > 1 ? t1 : 0.f) + (seg > 2 ? t2 : 0.f);
        const float bmid = t0 + t1, tot = (t0 + t1) + (t2 + t3);
        const float E3 = __expf(tot - bmid), E4 = __expf(bmid);
#pragma unroll
        for (int i = 0; i < 16; ++i) { const int t = seg * 16 + i; const float bc = off + cs[i];
            const float qv = bf2f(qw[i]) * 0.08838834764831845f;
            const float e1 = __expf(fminf(fmaxf(bc - bmid, -80.f), 80.f)), e2 = __builtin_amdgcn_rcpf(e1);
            const float qt = qv * e1, kt = kf[i] * e2;
            *(LAS bf16*)(L + IMG_Q + t * PH + k * 2) = (bf16)f2bf(qt);
            *(LAS bf16*)(L + IMG_K + t * PH + k * 2) = (bf16)f2bf(kt);
            *(LAS bf16*)(L + IMG_KH + t * PH + k * 2) = (bf16)f2bf(kt * E3);
            *(LAS bf16*)(L + IMG_V + t * PH + k * 2) = iw[i];
            if (STORE) colp[(size_t)i * LDP + C_HQ] = (bf16)f2bf(qt * E4); }
        if (STORE && seg == 0) DD[unit * 128 + k] = __expf(tot);
        __syncthreads();
        if (next < 2048) { const bf16* cp0 = PROJ + (size_t)((next >> 9) * SEQ + (next & 63) * 64 + seg * 16) * LDP + ((next >> 6) & 7) * 128 + k;
#pragma unroll
            for (int i = 0; i < 16; ++i) { fw[i] = cp0[(size_t)i * LDP + C_HF]; qw[i] = cp0[(size_t)i * LDP + C_HQ]; iw[i] = cp0[(size_t)i * LDP + C_HI]; } }
        const int tg = F.wave & 1, vt = F.wave >> 1;
        f32x16 oacc = zero16();
#pragma unroll
        for (int mt = 0; mt < 2; ++mt) {
            if (mt <= tg) {
                f32x16 s = zero16();
#pragma unroll
                for (int ks = 0; ks < 8; ++ks) { const bf16x8 a = *(const LAS bf16x8*)(L + IMG_K + (32 * mt + r) * PH + (16 * ks + 8 * h) * 2); const bf16x8 b = *(const LAS bf16x8*)(L + IMG_Q + (32 * tg + r) * PH + (16 * ks + 8 * h) * 2); s = mfma32(a, b, s); }
                if (mt == tg) {
#pragma unroll
                    for (int i = 0; i < 16; ++i) { const int sr = (i & 3) + 8 * (i >> 2) + 4 * h; if (sr > r) s[i] = 0.f; } }
                const unsigned a0 = lbase + IMG_V + (32 * mt + 4 * h) * PH + (32 * vt) * 2 + trl;
                const bf16x8 af0 = tr_frag(a0, a0 + 8 * PH), af1 = tr_frag(a0 + 16 * PH, a0 + 24 * PH);
                oacc = mfma32(af0, pack8(s, 0), oacc); oacc = mfma32(af1, pack8(s, 1), oacc);
            }
        }
        if (STORE) {   bf16* orow = OI + (size_t)(tok0 + 32 * tg + r) * 1024 + hh * 128 + 32 * vt + 4 * h;
#pragma unroll
            for (int g = 0; g < 4; ++g) { v2u w; w.x = pkc(oacc[4 * g], oacc[4 * g + 1]); w.y = pkc(oacc[4 * g + 2], oacc[4 * g + 3]); *(v2u*)(orow + 8 * g) = w; } }
        {   bf16x8 bv0, bv1, bv2, bv3; const unsigned rb = lbase + IMG_V + (8 * h) * PH + (32 * vt) * 2 + trl;
            tr_read8(rb, rb + 4 * PH, rb + 16 * PH, rb + 20 * PH, rb + 32 * PH, rb + 36 * PH, rb + 48 * PH, rb + 52 * PH, bv0, bv1, bv2, bv3);
#pragma unroll
            for (int kk2 = 0; kk2 < 2; ++kk2) { const int kt = 2 * (F.wave & 1) + kk2;
                bf16x8 av0, av1, av2, av3; const unsigned ra = lbase + IMG_KH + (8 * h) * PH + (32 * kt) * 2 + trl;
                tr_read8(ra, ra + 4 * PH, ra + 16 * PH, ra + 20 * PH, ra + 32 * PH, ra + 36 * PH, ra + 48 * PH, ra + 52 * PH, av0, av1, av2, av3);
                f32x16 u = zero16(); u = mfma32(av0, bv0, u); u = mfma32(av1, bv1, u); u = mfma32(av2, bv2, u); u = mfma32(av3, bv3, u);
                if (STORE) { bf16* up = U + (size_t)unit * 16384 + 32 * vt + r;
#pragma unroll
                    for (int i = 0; i < 16; ++i) { const int kr = 32 * kt + (i & 3) + 8 * (i >> 2) + 4 * h; up[kr * 128] = (bf16)f2bf(u[i]); } } } }
        __syncthreads();
        unit = next;
    }
}
__device__ __forceinline__ void hgrn_scan(Frame& F) {
    const bf16* U = (const bf16*)(F.ws + WS_U); bf16* SPo = (bf16*)(F.ws + WS_SP); const float* DD = (const float*)(F.ws + WS_DD);
    for (int idx = F.vcu * 512 + F.tid; idx < 32 * 4096; idx += F.G * 512) {
        const int bh = idx >> 12, e0 = (idx & 4095) * 4, k = e0 >> 7;
        float S0 = 0.f, S1 = 0.f, S2 = 0.f, S3 = 0.f;
        for (int c0 = 0; c0 < 64; c0 += 8) {
            v2u u[8]; float dv[8];
#pragma unroll
            for (int i = 0; i < 8; ++i) { const int unit = bh * 64 + c0 + i; u[i] = *(const v2u*)(U + (size_t)unit * 16384 + e0); dv[i] = DD[unit * 128 + k]; }
#pragma unroll
            for (int i = 0; i < 8; ++i) { const int unit = bh * 64 + c0 + i;
                v2u o; o.x = pkc(S0, S1); o.y = pkc(S2, S3);
                *(v2u*)(SPo + (size_t)unit * 16384 + e0) = o;
                S0 = dv[i] * S0 + bflo(u[i].x); S1 = dv[i] * S1 + bfhi(u[i].x); S2 = dv[i] * S2 + bflo(u[i].y); S3 = dv[i] * S3 + bfhi(u[i].y); }
        }
    }
}
__device__ __forceinline__ void hgrn_passB(Frame& F) {
    const bf16* PROJ = (const bf16*)(F.ws + WS_PROJ); const bf16* OI = (const bf16*)(F.ws + WS_OI); const bf16* SP = (const bf16*)(F.ws + WS_SP); bf16* Y = (bf16*)(F.ws + WS_B);
    const float* gain = F.in[IN_HG_NORM];
    LAS unsigned char* L = F.lds; const unsigned lbase = (unsigned)(size_t)L;
    LAS float* ss = (LAS float*)(L + 128 * PH);
    const int lane = F.lane, r = lane & 31, h = lane >> 5;
    const unsigned trl = (unsigned)(((lane & 15) >> 2) * PH + (16 * ((lane >> 4) & 1) + 4 * (lane & 3)) * 2);
    for (int unit = F.vcu; unit < 2048; unit += F.G) {
        const int hh = (unit >> 6) & 7, c = unit & 63, tok0 = (unit >> 9) * SEQ + c * 64;
        const int tg = F.wave & 1, vt = F.wave >> 1;
        bf16x8 qb_[8];
        {   const bf16* qrow = PROJ + (size_t)(tok0 + 32 * tg + r) * LDP + C_HQ + hh * 128 + 8 * h;
#pragma unroll
            for (int ks = 0; ks < 8; ++ks) qb_[ks] = *(const bf16x8*)(qrow + 16 * ks); }
#pragma unroll
        for (int i = 0; i < 4; ++i) { const int e = (i * 512 + F.tid) * 8, kr = e >> 7, vc = e & 127; *(LAS v4u*)(L + kr * PH + vc * 2) = *(const v4u*)(SP + (size_t)unit * 16384 + e); }
        __syncthreads();
        f32x16 acc = zero16();
        if (c > 0) {
#pragma unroll
            for (int kq = 0; kq < 2; ++kq) { const unsigned ra = lbase + (64 * kq + 8 * h) * PH + (32 * vt) * 2 + trl; bf16x8 a0, a1, a2, a3;
                tr_read8(ra, ra + 4 * PH, ra + 16 * PH, ra + 20 * PH, ra + 32 * PH, ra + 36 * PH, ra + 48 * PH, ra + 52 * PH, a0, a1, a2, a3);
                acc = mfma32(a0, qb_[4 * kq], acc); acc = mfma32(a1, qb_[4 * kq + 1], acc); acc = mfma32(a2, qb_[4 * kq + 2], acc); acc = mfma32(a3, qb_[4 * kq + 3], acc); }
        }
        const int tok = tok0 + 32 * tg + r; const int vb = hh * 128 + 32 * vt + 4 * h;
        float sq = 0.f;
#pragma unroll
        for (int g = 0; g < 4; ++g) { const v2u w = *(const v2u*)(OI + (size_t)tok * 1024 + vb + 8 * g);
            acc[4 * g] += bflo(w.x); acc[4 * g + 1] += bfhi(w.x); acc[4 * g + 2] += bflo(w.y); acc[4 * g + 3] += bfhi(w.y);
            sq += (acc[4 * g] * acc[4 * g] + acc[4 * g + 1] * acc[4 * g + 1]) + (acc[4 * g + 2] * acc[4 * g + 2] + acc[4 * g + 3] * acc[4 * g + 3]); }
        sq += __shfl_xor(sq, 32);
        if (h == 0) ss[vt * 64 + 32 * tg + r] = sq;
        __syncthreads();
        const int tl = 32 * tg + r;
        const float rstd = 1.0f / sqrtf(((ss[tl] + ss[64 + tl]) + (ss[128 + tl] + ss[192 + tl])) * (1.f / 128.f) + EPS);
#pragma unroll
        for (int g = 0; g < 4; ++g) { const int vl = 32 * vt + 4 * h + 8 * g; const f32x4 gn = *(const f32x4*)(gain + vl);
            const v2u gw = *(const v2u*)(PROJ + (size_t)tok * LDP + C_HG + hh * 128 + vl);
            const float g0 = bflo(gw.x), g1 = bfhi(gw.x), g2 = bflo(gw.y), g3 = bfhi(gw.y);
            v2u w; w.x = pkc(acc[4 * g] * rstd * gn.x * (g0 / (1.0f + __expf(-g0))), acc[4 * g + 1] * rstd * gn.y * (g1 / (1.0f + __expf(-g1))));
            w.y = pkc(acc[4 * g + 2] * rstd * gn.z * (g2 / (1.0f + __expf(-g2))), acc[4 * g + 3] * rstd * gn.w * (g3 / (1.0f + __expf(-g3))));
            *(v2u*)(Y + (size_t)tok * DM + hh * 128 + vl) = w; }
        __syncthreads();
    }
}
constexpr int KP = 144;
constexpr int C_MSK_ = 256 * 144 + 256 * 272 + 16384;
constexpr int RB = 8192;
constexpr int A_K = 0, A_V = 6 * RB, A_VX = 12 * RB, A_CK = A_VX + 64 * PH, A_MSK = C_MSK_, A_IMP = A_V;
constexpr int C_KI = 0, C_VX = 256 * KP, C_IMP = C_VX + 256 * PH, C_MSK = C_IMP + 16384;
static_assert(C_MSK + 2048 <= RING_BYTES && C_MSK >= A_VX, "attention LDS map");
constexpr float QSCALE = 0.125f * 1.4426950408889634f;
constexpr float NEGBIG = -1.0e30f;

__device__ __forceinline__ void tr_frag4(unsigned a, int pitch8, int dstep, bf16x8& f00, bf16x8& f01, bf16x8& f10, bf16x8& f11) {
    s16x4 l0, h0, l1, h1, l2, h2, l3, h3;
    const unsigned b0 = a, b1 = a + dstep, b2 = a + 2 * pitch8, b3 = a + 2 * pitch8 + dstep;
    asm volatile("ds_read_b64_tr_b16 %0, %8\n\tds_read_b64_tr_b16 %1, %9\n\tds_read_b64_tr_b16 %2, %10\n\tds_read_b64_tr_b16 %3, %11\n\t"
                 "ds_read_b64_tr_b16 %4, %12\n\tds_read_b64_tr_b16 %5, %13\n\tds_read_b64_tr_b16 %6, %14\n\tds_read_b64_tr_b16 %7, %15\n\ts_waitcnt lgkmcnt(0)"
                 : "=&v"(l0), "=&v"(h0), "=&v"(l1), "=&v"(h1), "=&v"(l2), "=&v"(h2), "=&v"(l3), "=&v"(h3)
                 : "v"(b0), "v"(b0 + pitch8), "v"(b1), "v"(b1 + pitch8), "v"(b2), "v"(b2 + pitch8), "v"(b3), "v"(b3 + pitch8) : "memory");
    f00 = __builtin_shufflevector(l0, h0, 0, 1, 2, 3, 4, 5, 6, 7); f01 = __builtin_shufflevector(l1, h1, 0, 1, 2, 3, 4, 5, 6, 7);
    f10 = __builtin_shufflevector(l2, h2, 0, 1, 2, 3, 4, 5, 6, 7); f11 = __builtin_shufflevector(l3, h3, 0, 1, 2, 3, 4, 5, 6, 7);
}
__device__ __forceinline__ void qk_tile(const LAS unsigned char* Kimg, const bf16x8 (&qf)[4], f32x16& s0, f32x16& s1, int r, int h) {
    s0 = zero16(); s1 = zero16();
#pragma unroll
    for (int ks = 0; ks < 4; ++ks) { const bf16x8 a0 = *(const LAS bf16x8*)(Kimg + r * KP + (16 * ks + 8 * h) * 2), a1 = *(const LAS bf16x8*)(Kimg + (32 + r) * KP + (16 * ks + 8 * h) * 2);
        s0 = mfma32(a0, qf[ks], s0); s1 = mfma32(a1, qf[ks], s1); }
}
template <int MODE> __device__ __forceinline__ void mask_tile(f32x16& s0, f32x16& s1, int tl, int h, bool sel) {
#pragma unroll
    for (int i = 0; i < 16; ++i) { const int k0 = (i & 3) + 8 * (i >> 2) + 4 * h, k1 = k0 + 32;
        bool v0 = sel, v1 = sel;
        if (MODE == 1) { v0 = v0 && (k0 <= tl); v1 = v1 && (k1 <= tl); }
        if (MODE == 2) { v0 = v0 && (k0 > tl); v1 = v1 && (k1 > tl); }
        s0[i] = v0 ? s0[i] : NEGBIG; s1[i] = v1 ? s1[i] : NEGBIG; }
}
template <int MODE> __device__ __forceinline__ void softmax_tile(f32x16& s0, f32x16& s1, float& m, float& l, f32x16& o0, f32x16& o1, int tl, int h, bool sel, int klo_ = 0, int khi_ = 63) {
    if (MODE != 0) {
        const int tlh = tl - 4 * h, loh = klo_ - 4 * h, hih = khi_ - 4 * h;
#pragma unroll
        for (int i = 0; i < 16; ++i) { const int c0 = (i & 3) + 8 * (i >> 2), c1 = c0 + 32;
            const bool v0 = (MODE == 1) ? (c0 <= tlh) : (MODE == 2) ? (c0 > tlh) : (c0 >= loh && c0 <= hih), v1 = (MODE == 1) ? (c1 <= tlh) : (MODE == 2) ? (c1 > tlh) : (c1 >= loh && c1 <= hih);
            s0[i] = v0 ? s0[i] : NEGBIG; s1[i] = v1 ? s1[i] : NEGBIG; } }
    float mx = fmaxf(s0[0], s1[0]);
#pragma unroll
    for (int i = 1; i < 16; ++i) mx = fmaxf(mx, fmaxf(s0[i], s1[i]));
    mx = fmaxf(mx, __shfl_xor(mx, 32));
    const float mn = sel ? fmaxf(m, mx) : m;
    if (__ballot(mn > m) != 0ull) { const float alpha = __builtin_amdgcn_exp2f(m - mn); l *= alpha;
#pragma unroll
        for (int i = 0; i < 16; ++i) { o0[i] *= alpha; o1[i] *= alpha; } }
    m = mn;
    const float me = sel ? mn : 1.0e30f; float sum = 0.f;
#pragma unroll
    for (int i = 0; i < 16; ++i) { s0[i] = __builtin_amdgcn_exp2f(s0[i] - me); s1[i] = __builtin_amdgcn_exp2f(s1[i] - me); sum += s0[i] + s1[i]; }
    l += sum;
}
__device__ __forceinline__ void pv_tile(unsigned vaddr, const f32x16& p0, const f32x16& p1, f32x16& o0, f32x16& o1, int h, unsigned trl) {
    bf16x8 f00, f01, f10, f11;
    tr_frag4(vaddr + (4 * h) * KP + trl, 8 * KP, 64, f00, f01, f10, f11);
    { const bf16x8 pa = pack8(p0, 0), pb = pack8(p0, 1); o0 = mfma32(f00, pa, o0); o1 = mfma32(f01, pa, o1); o0 = mfma32(f10, pb, o0); o1 = mfma32(f11, pb, o1); }
    tr_frag4(vaddr + (32 + 4 * h) * KP + trl, 8 * KP, 64, f00, f01, f10, f11);
    { const bf16x8 pa = pack8(p1, 0), pb = pack8(p1, 1); o0 = mfma32(f00, pa, o0); o1 = mfma32(f01, pa, o1); o0 = mfma32(f10, pb, o0); o1 = mfma32(f11, pb, o1); }
}

template <int VAR> __device__ __forceinline__ void attn_cmp_unit(Frame& F, int b, int g, int qb, int uidx) {
    const bf16* PROJ = (const bf16*)(F.ws + WS_PROJ); float* ONSA = (float*)(F.ws + (VAR ? WS_B : WS_ONSA));
    LAS unsigned char* L = F.lds; const unsigned lbase = (unsigned)(size_t)L;
    const int lane = F.lane, r = lane & 31, h = lane >> 5, w = F.wave;
    const int tl = 8 * w + (r >> 2), t = 64 * qb + tl, tok = b * SEQ + t, head = g * 4 + (r & 3);
    const unsigned trlX = (unsigned)(((lane & 15) >> 2) * PH + (16 * ((lane >> 4) & 1) + 4 * (lane & 3)) * 2);
    const bf16* qp = PROJ + (size_t)tok * LDP + C_NQ + head * 64 + 8 * h;
    bf16x8 qraw[4];
#pragma unroll
    for (int ks = 0; ks < 4; ++ks) { const v4u wv = *(const v4u*)(qp + 16 * ks); v4u p;
        p.x = pkc(bflo(wv.x) * QSCALE, bfhi(wv.x) * QSCALE); p.y = pkc(bflo(wv.y) * QSCALE, bfhi(wv.y) * QSCALE); p.z = pkc(bflo(wv.z) * QSCALE, bfhi(wv.z) * QSCALE); p.w = pkc(bflo(wv.w) * QSCALE, bfhi(wv.w) * QSCALE);
        qraw[ks] = __builtin_bit_cast(bf16x8, p); }
    const int nct = (4 * qb + 3 + 63) >> 6;
    const int nv = (t >= 31) ? ((t - 31) >> 4) + 1 : 0;
    float m = NEGBIG, l = 0.f;
    {   f32x16 o0 = zero16(), o1 = zero16();
#pragma unroll 1
        for (int ct = 0; ct < nct; ++ct) { const int hi_ = nv - 64 * ct - 1; const bool sel = hi_ >= 0;
            if (__ballot(sel) != 0ull) {
                f32x16 s0, s1; qk_tile(L + C_KI + 64 * ct * KP, qraw, s0, s1, r, h);
                softmax_tile<3>(s0, s1, m, l, o0, o1, tl, h, sel, 0, hi_);
                bf16x8 f00, f01, f10, f11; const unsigned va = lbase + C_VX + (64 * ct + 4 * h) * PH + trlX;
                { const bf16x8 pa = pack8(s0, 0), pb = pack8(s0, 1); tr_frag4(va, 8 * PH, 64, f00, f01, f10, f11); o0 = mfma32(f00, pa, o0); o1 = mfma32(f01, pa, o1); o0 = mfma32(f10, pb, o0); o1 = mfma32(f11, pb, o1); }
                { const bf16x8 pa = pack8(s1, 0), pb = pack8(s1, 1); tr_frag4(va + 32 * PH, 8 * PH, 64, f00, f01, f10, f11); o0 = mfma32(f00, pa, o0); o1 = mfma32(f01, pa, o1); o0 = mfma32(f10, pb, o0); o1 = mfma32(f11, pb, o1); } } }
        const float lt = l + __shfl_xor(l, 32);
        l = (lt > 0.f) ? 1.0f / lt : 0.f;
        const float gc = l / (1.0f + __expf(-bf2f(PROJ[(size_t)tok * LDP + C_GR + head * 3])));
        float* op = ONSA + (size_t)tok * 1024 + head * 64 + 4 * h;
#pragma unroll
        for (int gq = 0; gq < 4; ++gq) { *(f32x4*)(op + 8 * gq) = (f32x4){gc * o0[4 * gq], gc * o0[4 * gq + 1], gc * o0[4 * gq + 2], gc * o0[4 * gq + 3]}; *(f32x4*)(op + 32 + 8 * gq) = (f32x4){gc * o1[4 * gq], gc * o1[4 * gq + 1], gc * o1[4 * gq + 2], gc * o1[4 * gq + 3]}; }
    }
    f32x16 im0 = zero16(), im1 = zero16();
#pragma unroll 1
    for (int ct = 0; ct < nct; ++ct) { const int nvh = nv - 64 * ct - 4 * h;
        if (__ballot(nv > 64 * ct) != 0ull) {
            f32x16 s0, s1; qk_tile(L + C_KI + 64 * ct * KP, qraw, s0, s1, r, h);
#pragma unroll
            for (int i = 0; i < 16; ++i) { const int c0 = (i & 3) + 8 * (i >> 2); s0[i] = (c0 < nvh) ? __builtin_amdgcn_exp2f(s0[i] - m) * l : 0.f; s1[i] = (c0 + 32 < nvh) ? __builtin_amdgcn_exp2f(s1[i] - m) * l : 0.f; }
            bf16x8 f00, f01, f10, f11; const unsigned va = lbase + C_VX + (64 * ct + 4 * h) * PH + trlX + 128;
            { const bf16x8 pa = pack8(s0, 0), pb = pack8(s0, 1); tr_frag4(va, 8 * PH, 64, f00, f01, f10, f11); im0 = mfma32(f00, pa, im0); im1 = mfma32(f01, pa, im1); im0 = mfma32(f10, pb, im0); im1 = mfma32(f11, pb, im1); }
            { const bf16x8 pa = pack8(s1, 0), pb = pack8(s1, 1); tr_frag4(va + 32 * PH, 8 * PH, 64, f00, f01, f10, f11); im0 = mfma32(f00, pa, im0); im1 = mfma32(f01, pa, im1); im0 = mfma32(f10, pb, im0); im1 = mfma32(f11, pb, im1); } } }
#pragma unroll
    for (int i = 0; i < 16; ++i) { im0[i] += __shfl_xor(im0[i], 1); im0[i] += __shfl_xor(im0[i], 2); im1[i] += __shfl_xor(im1[i], 1); im1[i] += __shfl_xor(im1[i], 2); }
    LAS float* IMP = (LAS float*)(L + C_IMP);
    if ((r & 3) == 0) {
#pragma unroll
        for (int gq = 0; gq < 4; ++gq) { *(LAS f32x4*)(IMP + tl * 64 + 8 * gq + 4 * h) = (f32x4){im0[4 * gq], im0[4 * gq + 1], im0[4 * gq + 2], im0[4 * gq + 3]};
            *(LAS f32x4*)(IMP + tl * 64 + 32 + 8 * gq + 4 * h) = (f32x4){im1[4 * gq], im1[4 * gq + 1], im1[4 * gq + 2], im1[4 * gq + 3]}; }
    }
    LDS_WAIT();
#pragma unroll 1
    for (int ti = 0; ti < 8; ++ti) {
        const bool forced = (lane == 0) || (lane == qb) || (lane == qb - 1), causal = lane <= qb;
        const unsigned vb = __builtin_bit_cast(unsigned, IMP[(8 * w + ti) * 64 + lane]);
        const unsigned key = causal ? (((forced ? 0xFFFFFFC0u : (vb & ~63u))) | (unsigned)(63 - lane)) : 0u;
        unsigned T = 0u;
#pragma unroll 1
        for (int bit = 31; bit >= 0; --bit) { const unsigned cand = T | (1u << bit); if (__builtin_popcountll(__ballot(key >= cand)) >= 16) T = cand; }
        const unsigned long long mk = __ballot(causal && key >= T);
        if (lane == ti) ((LAS unsigned long long*)(L + C_MSK))[uidx * 64 + 8 * w + ti] = mk; }
    LDS_WAIT();
}

template <int VAR> __device__ __forceinline__ void attn_stream_unit(Frame& F, int b, int g, int qb, int uidx) {
    const bf16* PROJ = (const bf16*)(F.ws + WS_PROJ); const bf16* KC = (const bf16*)(F.ws + WS_KC); const bf16* VC = (const bf16*)(F.ws + WS_VC);
    const float* COS = (const float*)(F.ws + SM_COS); const float* SIN = (const float*)(F.ws + SM_SIN); float* ONSA = (float*)(F.ws + (VAR ? WS_B : WS_ONSA));
    LAS unsigned char* L = F.lds; const unsigned lbase = (unsigned)(size_t)L;
    const int lane = F.lane, r = lane & 31, h = lane >> 5, w = F.wave;
    const int tl = 8 * w + (r >> 2), t = 64 * qb + tl, tok = b * SEQ + t, head = g * 4 + (r & 3);
    const unsigned trlK = (unsigned)(((lane & 15) >> 2) * KP + (16 * ((lane >> 4) & 1) + 4 * (lane & 3)) * 2);
    const unsigned trlX = (unsigned)(((lane & 15) >> 2) * PH + (16 * ((lane >> 4) & 1) + 4 * (lane & 3)) * 2);
    const int srow = F.tid >> 3, spc = F.tid & 7;
    const bf16* qp = PROJ + (size_t)tok * LDP + C_NQ + head * 64 + 8 * h;
    const unsigned long long mymask = ((const LAS unsigned long long*)(L + C_MSK))[uidx * 64 + tl];
    bf16x8 qrot[4];
    {   float qa[4][8];
#pragma unroll
        for (int ks = 0; ks < 4; ++ks) { const v4u wv = *(const v4u*)(qp + 16 * ks);
            qa[ks][0] = bflo(wv.x); qa[ks][1] = bfhi(wv.x); qa[ks][2] = bflo(wv.y); qa[ks][3] = bfhi(wv.y); qa[ks][4] = bflo(wv.z); qa[ks][5] = bfhi(wv.z); qa[ks][6] = bflo(wv.w); qa[ks][7] = bfhi(wv.w); }
#pragma unroll
        for (int k2 = 0; k2 < 2; ++k2) { const float* cp = COS + t * 32 + 16 * k2 + 8 * h; const float* sp = SIN + t * 32 + 16 * k2 + 8 * h;
            const f32x4 c0 = *(const f32x4*)cp, c1 = *(const f32x4*)(cp + 4), s0 = *(const f32x4*)sp, s1 = *(const f32x4*)(sp + 4);
            float lo[8], hi[8];
#pragma unroll
            for (int j = 0; j < 8; ++j) { const float c = j < 4 ? c0[j & 3] : c1[j & 3], s = j < 4 ? s0[j & 3] : s1[j & 3]; lo[j] = (qa[k2][j] * c - qa[k2 + 2][j] * s) * QSCALE; hi[j] = (qa[k2 + 2][j] * c + qa[k2][j] * s) * QSCALE; }
            v4u p; p.x = pkc(lo[0], lo[1]); p.y = pkc(lo[2], lo[3]); p.z = pkc(lo[4], lo[5]); p.w = pkc(lo[6], lo[7]); qrot[k2] = __builtin_bit_cast(bf16x8, p);
            p.x = pkc(hi[0], hi[1]); p.y = pkc(hi[2], hi[3]); p.z = pkc(hi[4], hi[5]); p.w = pkc(hi[6], hi[7]); qrot[k2 + 2] = __builtin_bit_cast(bf16x8, p); }
    }
#if ATT_PARTS & 6
    {
        const int wv = F.wave, rr = (lane >> 2) & 7, chd = ((lane >> 5) << 2) | ((lane & 3) ^ (((wv & 1) << 1) | (rr >> 2)));
        const unsigned dsrc = (unsigned)(((b * SEQ + 8 * wv + rr) * LDP + g * 64 + chd * 8) * 2);
        const char* pbase = (const char*)PROJ;
        const int sK = (r >> 2) & 3; const unsigned rbK = (unsigned)(1024 * (r >> 3) + 64 * (r & 7));
        const unsigned aK0 = rbK + 16 * ((0 + h) ^ sK), aK1 = rbK + 16 * ((2 + h) ^ sK);
        const int q4 = (lane & 15) >> 2, p4 = lane & 3, blk = (lane >> 4) & 1;
        const unsigned lbV0 = (unsigned)(64 * (4 * h + q4) + 16 * ((2 * blk + (p4 >> 1)) ^ ((0 + h) & 3)) + 8 * (p4 & 1)), lbV1 = (unsigned)(64 * (4 * h + q4) + 16 * ((2 * blk + (p4 >> 1)) ^ ((2 + h) & 3)) + 8 * (p4 & 1));
#pragma unroll 1
        for (int br = 0; br < 2; ++br) {
            const int n = br ? ((qb < 8 ? qb : 8) + 1) : (qb + 1);
            const unsigned kcolb = (unsigned)((br ? C_KW : C_KS) * 2), vcolb = (unsigned)((br ? C_VW : C_VS) * 2);
#define TILE_OF(i) (br ? (qb - (i)) : (i))
#define DMA_TILE(i, buf) do { const char* tb_ = pbase + (size_t)(TILE_OF(i) * 64 * LDP * 2) + dsrc; \
                __builtin_amdgcn_global_load_lds((const unsigned*)(tb_ + kcolb), (LAS unsigned*)(L + A_K + (buf) * RB + 1024 * wv), 16, 0, 0); \
                __builtin_amdgcn_global_load_lds((const unsigned*)(tb_ + vcolb), (LAS unsigned*)(L + A_V + (buf) * RB + 1024 * wv), 16, 0, 0); } while (0)
            float m = NEGBIG, l = 0.f; f32x16 o0 = zero16(), o1 = zero16();
            const int np = (n + 1) >> 1;
            DMA_TILE(0, 0); if (n > 1) DMA_TILE(1, 1); if (n > 2) DMA_TILE(2, 2); if (n > 3) DMA_TILE(3, 3);
#pragma unroll 1
            for (int p = 0; p < np; ++p) {
                const int rem = n - 2 * (p + 1);
                if (rem >= 2) asm volatile("s_waitcnt vmcnt(4)" ::: "memory"); else if (rem == 1) asm volatile("s_waitcnt vmcnt(2)" ::: "memory"); else asm volatile("s_waitcnt vmcnt(0)" ::: "memory");
                __builtin_amdgcn_s_barrier(); asm volatile("" ::: "memory");
                { const int t4 = 2 * p + 4, sb = (p + 2) % 3 * 2; if (t4 < n) DMA_TILE(t4, sb); if (t4 + 1 < n) DMA_TILE(t4 + 1, sb + 1); }
#pragma unroll 1
                for (int i = 2 * p; i < 2 * p + 2 && i < n; ++i) { const int cb = (p % 3) * 2 + (i & 1);
                const bool sel = br ? true : (bool)((mymask >> i) & 1ull);
                if (__ballot(sel) != 0ull) {
                    const LAS unsigned char* Kb = L + A_K + cb * RB;
                    f32x16 sc0 = zero16(), sc1 = zero16();
                    {   const bf16x8 a00 = *(const LAS bf16x8*)(Kb + aK0), a01 = *(const LAS bf16x8*)(Kb + aK1), a02 = *(const LAS bf16x8*)(Kb + aK0 + 512), a03 = *(const LAS bf16x8*)(Kb + aK1 + 512);
                        const bf16x8 a10 = *(const LAS bf16x8*)(Kb + 4096 + aK0), a11 = *(const LAS bf16x8*)(Kb + 4096 + aK1), a12 = *(const LAS bf16x8*)(Kb + 4096 + aK0 + 512), a13 = *(const LAS bf16x8*)(Kb + 4096 + aK1 + 512);
                        sc0 = mfma32(a00, qrot[0], sc0); sc1 = mfma32(a10, qrot[0], sc1); sc0 = mfma32(a01, qrot[1], sc0); sc1 = mfma32(a11, qrot[1], sc1);
                        sc0 = mfma32(a02, qrot[2], sc0); sc1 = mfma32(a12, qrot[2], sc1); sc0 = mfma32(a03, qrot[3], sc0); sc1 = mfma32(a13, qrot[3], sc1); }
                    int lo_ = 0, hi_ = 63;
                    if (br == 0) { if (i == qb) hi_ = tl; } else { if (i == 0) hi_ = tl; if (i == 8) lo_ = tl + 1; }
                    if (lo_ == 0 && hi_ == 63) softmax_tile<0>(sc0, sc1, m, l, o0, o1, tl, h, sel); else softmax_tile<3>(sc0, sc1, m, l, o0, o1, tl, h, sel, lo_, hi_);
                    const unsigned vb = lbase + A_V + cb * RB;
#pragma unroll
                    for (int mt = 0; mt < 2; ++mt) {
                        s16x4 x0, x1, x2, x3, x4, x5, x6, x7; const unsigned va0 = vb + 4096 * mt + lbV0, va1 = vb + 4096 * mt + 1024 + lbV1;
                        asm volatile("ds_read_b64_tr_b16 %0, %8\n\tds_read_b64_tr_b16 %1, %9\n\tds_read_b64_tr_b16 %2, %8 offset:512\n\tds_read_b64_tr_b16 %3, %9 offset:512\n\t"
                                     "ds_read_b64_tr_b16 %4, %8 offset:2048\n\tds_read_b64_tr_b16 %5, %9 offset:2048\n\tds_read_b64_tr_b16 %6, %8 offset:2560\n\tds_read_b64_tr_b16 %7, %9 offset:2560\n\ts_waitcnt lgkmcnt(0)"
                                     : "=&v"(x0), "=&v"(x1), "=&v"(x2), "=&v"(x3), "=&v"(x4), "=&v"(x5), "=&v"(x6), "=&v"(x7) : "v"(va0), "v"(va1) : "memory");
                        const bf16x8 f00 = __builtin_shufflevector(x0, x1, 0, 1, 2, 3, 4, 5, 6, 7), f01 = __builtin_shufflevector(x2, x3, 0, 1, 2, 3, 4, 5, 6, 7);
                        const bf16x8 f10 = __builtin_shufflevector(x4, x5, 0, 1, 2, 3, 4, 5, 6, 7), f11 = __builtin_shufflevector(x6, x7, 0, 1, 2, 3, 4, 5, 6, 7);
                        const bf16x8 pa = pack8(mt ? sc1 : sc0, 0), pb = pack8(mt ? sc1 : sc0, 1);
                        o0 = mfma32(f00, pa, o0); o1 = mfma32(f01, pa, o1); o0 = mfma32(f10, pb, o0); o1 = mfma32(f11, pb, o1); }
                }
                }
            }
            __builtin_amdgcn_s_barrier(); asm volatile("" ::: "memory");
#undef TILE_OF
#undef DMA_TILE
            const float gsel = 1.0f / (1.0f + __expf(-bf2f(PROJ[(size_t)tok * LDP + C_GR + head * 3 + 1 + br])));
            const float sc = gsel / (l + __shfl_xor(l, 32));
            float* op = ONSA + (size_t)tok * 1024 + head * 64 + 4 * h;
#pragma unroll
            for (int gq = 0; gq < 4; ++gq) { const f32x4 c0 = *(const f32x4*)(op + 8 * gq), c1 = *(const f32x4*)(op + 32 + 8 * gq);
                *(f32x4*)(op + 8 * gq) = (f32x4){c0.x + sc * o0[4 * gq], c0.y + sc * o0[4 * gq + 1], c0.z + sc * o0[4 * gq + 2], c0.w + sc * o0[4 * gq + 3]};
                *(f32x4*)(op + 32 + 8 * gq) = (f32x4){c1.x + sc * o1[4 * gq], c1.y + sc * o1[4 * gq + 1], c1.z + sc * o1[4 * gq + 2], c1.w + sc * o1[4 * gq + 3]}; }
            asm volatile("s_waitcnt vmcnt(0)" ::: "memory");
        }
    }
#endif
}

__device__ __forceinline__ void cmp_layer2(Frame& F, int b, int g) {
    const int lane = F.lane, br = F.wave >> 2, fr = lane & 15, fq = lane >> 4;
    const bf16* hid = (const bf16*)(F.ws + WS_HIDC) + (size_t)((br * 16 + g * 4 + b) * 256 + (F.wave & 3) * 64) * 256;
    const bf16* w2t = (const bf16*)(F.ws + (br ? SM_W2VT : SM_W2KT));
    bf16* outp = (bf16*)(F.ws + (br ? WS_VC : WS_KC));
    f32x4 acc[4][4];
#pragma unroll
    for (int m = 0; m < 4; ++m)
#pragma unroll
        for (int n = 0; n < 4; ++n) acc[m][n] = (f32x4){0.f, 0.f, 0.f, 0.f};
#pragma unroll 2
    for (int ks = 0; ks < 8; ++ks) { bf16x8 af[4], bfr[4];
#pragma unroll
        for (int m = 0; m < 4; ++m) af[m] = *(const bf16x8*)(hid + (size_t)(16 * m + fr) * 256 + 32 * ks + 8 * fq);
#pragma unroll
        for (int n = 0; n < 4; ++n) bfr[n] = *(const bf16x8*)(w2t + (size_t)(16 * n + fr) * 256 + 32 * ks + 8 * fq);
#pragma unroll
        for (int m = 0; m < 4; ++m)
#pragma unroll
            for (int n = 0; n < 4; ++n) acc[m][n] = __builtin_amdgcn_mfma_f32_16x16x32_bf16(af[m], bfr[n], acc[m][n], 0, 0, 0); }
#pragma unroll
    for (int m = 0; m < 4; ++m)
#pragma unroll
        for (int n = 0; n < 4; ++n)
#pragma unroll
            for (int i = 0; i < 4; ++i) { const int c = (F.wave & 3) * 64 + 16 * m + 4 * fq + i; outp[((size_t)(b * 256 + c) * 4 + g) * 64 + 16 * n + fr] = (bf16)f2bf(acc[m][n][i]); }
    VM_WAIT(); __syncthreads();
}
template <int VAR> __device__ __forceinline__ void attn_phase(Frame& F) {
    for (int wg = F.vcu; wg < 256; wg += F.G) { const int bg = wg >> 4, i = wg & 15, b = bg >> 2, g = bg & 3;
#if !NAIVE_CMP
        if (VAR == 0) cmp_layer2(F, b, g);
#endif
        {
            const bf16* KC = (const bf16*)(F.ws + WS_KC); const bf16* VC = (const bf16*)(F.ws + WS_VC); LAS unsigned char* L = F.lds;
            const int spc = F.tid & 7;
#pragma unroll
            for (int q = 0; q < 4; ++q) { const int c = (F.tid >> 3) + 64 * q; v4u kv = (v4u){0u, 0u, 0u, 0u}, vv = (v4u){0u, 0u, 0u, 0u};
                if (c < 255) { kv = *(const v4u*)(KC + ((size_t)(b * 256 + c) * 4 + g) * 64 + spc * 8); vv = *(const v4u*)(VC + ((size_t)(b * 256 + c) * 4 + g) * 64 + spc * 8); }
                *(LAS v4u*)(L + C_KI + c * KP + spc * 16) = kv; *(LAS v4u*)(L + C_VX + c * PH + spc * 16) = vv;
                unsigned ag[4];
#pragma unroll
                for (int jj = 0; jj < 4; ++jj) { const int j0 = 8 * spc + 2 * jj, j1 = j0 + 1; ag[jj] = ((c >= 4 * j0 - 1 && c <= 4 * j0 + 3 && c < 255) ? 0x3F80u : 0u) | ((c >= 4 * j1 - 1 && c <= 4 * j1 + 3 && c < 255) ? 0x3F800000u : 0u); }
                *(LAS v4u*)(L + C_VX + c * PH + 128 + spc * 16) = (v4u){ag[0], ag[1], ag[2], ag[3]}; }
            __syncthreads();
        }
#pragma unroll 1
        for (int u = 0; u < 4; ++u) { const int qb = (u == 0) ? 63 - i : (u == 1) ? 32 + i : (u == 2) ? 31 - i : i; if (VAR != 5) attn_cmp_unit<VAR>(F, b, g, qb, u); }
        VM_WAIT(); __syncthreads();
#pragma unroll 1
        for (int u = 0; u < 4; ++u) { const int qb = (u == 0) ? 63 - i : (u == 1) ? 32 + i : (u == 2) ? 31 - i : i; if (VAR != 4) attn_stream_unit<VAR>(F, b, g, qb, u); } }
}
__device__ __forceinline__ void n4_nsanorm(Frame& F) {
    const float* ONSA = (const float*)(F.ws + WS_ONSA); bf16* Y = (bf16*)(F.ws + WS_B); const float* gain = F.in[IN_NSA_NORM];
    const int gw = F.vcu * NWAVES + F.wave, NGW = F.G * NWAVES;
    for (int tok = gw; tok < NTOK; tok += NGW) {
        const f32x4* xr = (const f32x4*)(ONSA + (size_t)tok * 1024) + F.lane; const f32x4* gr = (const f32x4*)gain + F.lane;
        f32x4 v[4]; float s = 0.f;
#pragma unroll
        for (int j = 0; j < 4; ++j) { v[j] = xr[64 * j]; s += (v[j].x * v[j].x + v[j].y * v[j].y) + (v[j].z * v[j].z + v[j].w * v[j].w); }
        const float rstd = 1.0f / sqrtf(wave_sum(s) * (1.f / 1024.f) + EPS);
        unsigned long long* o8 = (unsigned long long*)(Y + (size_t)tok * DM + 1024) + F.lane;
#pragma unroll
        for (int j = 0; j < 4; ++j) { const f32x4 g = gr[64 * j]; o8[64 * j] = (unsigned long long)pk2(v[j].x * rstd * g.x, v[j].y * rstd * g.y) | ((unsigned long long)pk2(v[j].z * rstd * g.z, v[j].w * rstd * g.w) << 32); }
    }
}
__device__ __forceinline__ void p6_router(Frame& F) {
    const float* X2 = F.out;
    int* EID = (int*)(F.ws + SM_EID); float* EW = (float*)(F.ws + SM_EW); float* RSTD = (float*)(F.ws + SM_RSTD);
    const int gw = F.vcu * NWAVES + F.wave, NGW = F.G * NWAVES;
    {
        LAS float* scr = (LAS float*)(F.lds + RING_OFF + F.wave * 16384);
        bf16* WGUT = (bf16*)(F.ws + WS_WGUT); bf16* WDT = (bf16*)(F.ws + WS_WDT);
        for (int rep = 0; rep < (DUP == 60 ? 2 : 1); ++rep)
        for (int it = gw; it < 3 * 16384; it += NGW) { const int which = it >> 14, r = it & 16383, e = r >> 9, q = r & 511;
            if (which < 2) transpose_item(F.in[which ? IN_W_UP : IN_W_GATE] + (size_t)e * DM * 512, 512, 512, WGUT + (size_t)e * 1024 * DM, DM, scr, 64 * (q >> 4), 32 * (q & 15), F.lane, which ? 4 : 0);
            else transpose_item(F.in[IN_W_DOWN] + (size_t)e * 512 * DM, DM, DM, WDT + (size_t)e * DM * 512, 512, scr, 64 * (q >> 6), 32 * (q & 63), F.lane); }
    }
    const bf16* RTH = (const bf16*)(F.ws + SM_RTH); const bf16* RTL = (const bf16*)(F.ws + SM_RTL);
    LAS float* LG = (LAS float*)(F.lds + RING_OFF + (F.wave >> 1) * 8192);
    const int fr = F.lane & 15, fq = F.lane >> 4, kh = F.wave & 1;
    for (int rep = 0; rep < (DUP == 61 ? 2 : 1); ++rep)
    for (int g0 = F.vcu * 4; g0 < NTOK / 16; g0 += F.G * 4) { const int grp = g0 + (F.wave >> 1);
        const float* xr = X2 + (size_t)(grp * 16 + fr) * DM + kh * 1024 + 8 * fq;
        f32x4 acc[3]; float ssq = 0.f;
#pragma unroll
        for (int n = 0; n < 3; ++n) acc[n] = (f32x4){0.f, 0.f, 0.f, 0.f};
#pragma unroll 2
        for (int ks = 0; ks < 32; ++ks) { const f32x4 xa = *(const f32x4*)(xr + 32 * ks), xb = *(const f32x4*)(xr + 32 * ks + 4);
            ssq += (xa.x * xa.x + xa.y * xa.y) + (xa.z * xa.z + xa.w * xa.w) + (xb.x * xb.x + xb.y * xb.y) + (xb.z * xb.z + xb.w * xb.w);
            v4u ph, pl;
            { const unsigned h0 = f2bf(xa.x), h1 = f2bf(xa.y), h2 = f2bf(xa.z), h3 = f2bf(xa.w), h4 = f2bf(xb.x), h5 = f2bf(xb.y), h6 = f2bf(xb.z), h7 = f2bf(xb.w);
              ph.x = h0 | (h1 << 16); ph.y = h2 | (h3 << 16); ph.z = h4 | (h5 << 16); ph.w = h6 | (h7 << 16);
              pl.x = pk2(xa.x - bf2f(h0), xa.y - bf2f(h1)); pl.y = pk2(xa.z - bf2f(h2), xa.w - bf2f(h3)); pl.z = pk2(xb.x - bf2f(h4), xb.y - bf2f(h5)); pl.w = pk2(xb.z - bf2f(h6), xb.w - bf2f(h7)); }
            const bf16x8 ahi = __builtin_bit_cast(bf16x8, ph), alo = __builtin_bit_cast(bf16x8, pl);
#pragma unroll
            for (int n = 0; n < 3; ++n) { const size_t wo = (size_t)(16 * n + fr) * DM + kh * 1024 + 32 * ks + 8 * fq; const bf16x8 bh = *(const bf16x8*)(RTH + wo), bl = *(const bf16x8*)(RTL + wo);
                acc[n] = __builtin_amdgcn_mfma_f32_16x16x32_bf16(ahi, bh, acc[n], 0, 0, 0); acc[n] = __builtin_amdgcn_mfma_f32_16x16x32_bf16(alo, bh, acc[n], 0, 0, 0); acc[n] = __builtin_amdgcn_mfma_f32_16x16x32_bf16(ahi, bl, acc[n], 0, 0, 0); } }
        ssq += __shfl_xor(ssq, 16); ssq += __shfl_xor(ssq, 32);
#pragma unroll
        for (int n = 0; n < 3; ++n)
#pragma unroll
            for (int i = 0; i < 4; ++i) LG[kh * 768 + (4 * fq + i) * 48 + 16 * n + fr] = acc[n][i];
        if (fq == 0) LG[1536 + kh * 16 + fr] = ssq;
        __syncthreads();
        if (kh == 0 && F.lane < 16) {
            const int tok = grp * 16 + F.lane; const LAS float* L = LG + F.lane * 48;
            const float rstd = 1.0f / sqrtf((LG[1536 + F.lane] + LG[1552 + F.lane]) * (1.f / DM) + EPS);
            float gl[4];
#pragma unroll
            for (int i = 0; i < 4; ++i) gl[i] = (L[i] + L[768 + i]) * rstd + F.in[IN_B_GROUP][i];
            int gs = 0; float gm = gl[0];
#pragma unroll
            for (int i = 1; i < 4; ++i) if (gl[i] > gm) { gm = gl[i]; gs = i; }
            float den = 0.f;
#pragma unroll
            for (int i = 0; i < 4; ++i) den += expf(gl[i] - gm);
            const float gwt = 1.0f / den;
            float el[8];
#pragma unroll
            for (int i = 0; i < 8; ++i) el[i] = (L[4 + gs * 8 + i] + L[768 + 4 + gs * 8 + i]) * rstd + F.in[IN_B_ROUTER][gs * 8 + i];
            int i1 = 0; float v1 = el[0];
#pragma unroll
            for (int i = 1; i < 8; ++i) if (el[i] > v1) { v1 = el[i]; i1 = i; }
            int i2 = -1; float v2 = -3.0e38f;
#pragma unroll
            for (int i = 0; i < 8; ++i) if (i != i1 && el[i] > v2) { v2 = el[i]; i2 = i; }
            const float e2 = expf(v2 - v1), w1 = gwt / (1.0f + e2), w2 = gwt * e2 / (1.0f + e2);
            const int id1 = gs * 8 + i1, id2 = gs * 8 + i2;
            int* TILEE = (int*)(F.ws + SM_TILEE); float* SW = (float*)(F.ws + SM_SW); float* SRS = (float*)(F.ws + SM_SRS); int* TSLOT = (int*)(F.ws + SM_TSLOT);
            int slot2[2];
#pragma unroll
            for (int kk = 0; kk < 2; ++kk) { const int e = kk ? id2 : id1; int slot = 0;
                if (rep == 0) {
                    const unsigned p = __hip_atomic_fetch_add(F.ctl + CW_CNT + e, 1u, RLX_AGENT);
                    gu32* tm = F.ctl + CW_TMAP + e * 128 + (p >> 8);
                    if ((p & 255u) == 0u) { const unsigned t = __hip_atomic_fetch_add(F.ctl + CW_NT, 1u, RLX_AGENT); TILEE[t] = e; __hip_atomic_store(tm, t + 1u, RLX_AGENT); }
                    unsigned v = 0u, spins = 0u;
                    while ((v = __hip_atomic_load(tm, RLX_AGENT)) == 0u) { __builtin_amdgcn_s_sleep(1); if (++spins > (1u << 22)) { __hip_atomic_store(F.ctl + CW_TMO, 1u, RLX_AGENT); v = 1u; break; } }
                    slot = (int)((v - 1u) * 256u + (p & 255u));
                    SW[slot] = kk ? w2 : w1; SRS[slot] = rstd; TSLOT[tok * 2 + kk] = slot;
                } else slot = TSLOT[tok * 2 + kk];
                slot2[kk] = slot; }
            LG[1600 + F.lane * 2] = __builtin_bit_cast(float, slot2[0]); LG[1600 + F.lane * 2 + 1] = __builtin_bit_cast(float, slot2[1]);
        }
        __syncthreads();
        {
            bf16* XG = (bf16*)(F.ws + WS_XG); const float* gain = F.in[IN_FFN_NORM];
#pragma unroll 1
            for (int tq = 0; tq < 8; ++tq) { const int ti = kh * 8 + tq; const int s0 = __builtin_bit_cast(int, LG[1600 + ti * 2]), s1 = __builtin_bit_cast(int, LG[1600 + ti * 2 + 1]);
                const f32x4* xr4 = (const f32x4*)(X2 + (size_t)(grp * 16 + ti) * DM) + F.lane; const f32x4* gr4 = (const f32x4*)gain + F.lane;
                v2u* d0 = (v2u*)(XG + (size_t)s0 * DM) + F.lane; v2u* d1 = (v2u*)(XG + (size_t)s1 * DM) + F.lane;
#pragma unroll
                for (int j = 0; j < 8; ++j) { const f32x4 x = xr4[64 * j], g = gr4[64 * j]; v2u w; w.x = pk2(x.x * g.x, x.y * g.y); w.y = pk2(x.z * g.z, x.w * g.w); d0[64 * j] = w; d1[64 * j] = w; } }
        }
        __syncthreads();
    }
}
__device__ __forceinline__ void p7_assign(Frame& F) {
    LAS int* pst = (LAS int*)(F.lds);
    if (F.tid == 0) { int acc = 0; for (int e = 0; e < 32; ++e) { const int c = (int)__hip_atomic_load(F.ctl + CW_CNT + e, RLX_AGENT); pst[e] = acc; pst[64 + e] = c; acc += ((c + 255) >> 8) << 8; } pst[32] = acc; }
    __syncthreads();
    int* TILEE = (int*)(F.ws + SM_TILEE);
    if (F.vcu == 0 && F.tid <= MAXTILE) { const int tl = F.tid; int e = -1;
        if (tl == MAXTILE) { TILEE[MAXTILE] = pst[32] >> 8; }
        else { for (int k = 0; k < 32; ++k) if ((pst[k] >> 8) <= tl && tl < (pst[k + 1] >> 8)) e = k; TILEE[tl] = e; } }
    if (F.vcu == 0 && F.tid < 64) { int* CNT = TILEE + 192; if (F.tid < 32) { CNT[F.tid] = pst[64 + F.tid]; CNT[32 + F.tid] = pst[F.tid]; } }
    const int* EID = (const int*)(F.ws + SM_EID); const float* EW = (const float*)(F.ws + SM_EW);
    int* TSLOT = (int*)(F.ws + SM_TSLOT); int* STOK = (int*)(F.ws + SM_STOK); float* SW = (float*)(F.ws + SM_SW);
    bf16* XG = (bf16*)(F.ws + WS_XG); const float* RSTD = (const float*)(F.ws + SM_RSTD); float* SRS = (float*)(F.ws + SM_SRS); const float* gain = F.in[IN_FFN_NORM];
    const int gw = F.vcu * NWAVES + F.wave, NGW = F.G * NWAVES;
    for (int rep = 0; rep < (DUP == 70 ? 2 : 1); ++rep)
    for (int tok = gw; tok < NTOK; tok += NGW) {
        int slot = 0;
        if (F.lane < 2) { if (rep == 0) { const int e = EID[tok * 2 + F.lane]; const int p = (int)__hip_atomic_fetch_add(F.ctl + CW_CUR + e, 1u, RLX_AGENT); slot = pst[e] + p;
            STOK[slot] = tok; SW[slot] = EW[tok * 2 + F.lane]; SRS[slot] = RSTD[tok]; TSLOT[tok * 2 + F.lane] = slot; } else slot = TSLOT[tok * 2 + F.lane]; }
        const int s0 = __shfl(slot, 0), s1 = __shfl(slot, 1);
        const f32x4* xr = (const f32x4*)(F.out + (size_t)tok * DM) + F.lane; const f32x4* gr = (const f32x4*)gain + F.lane;
        v2u* d0 = (v2u*)(XG + (size_t)s0 * DM) + F.lane; v2u* d1 = (v2u*)(XG + (size_t)s1 * DM) + F.lane;
#pragma unroll
        for (int j = 0; j < 8; ++j) { const f32x4 x = xr[64 * j], g = gr[64 * j]; v2u w; w.x = pk2(x.x * g.x, x.y * g.y); w.y = pk2(x.z * g.z, x.w * g.w); d0[64 * j] = w; d1[64 * j] = w; }
    }
}
__device__ __forceinline__ void n8_moe(Frame& F) {
    const int* TILEE = (const int*)(F.ws + SM_TILEE); const int* CNT = TILEE + 192; const float* SW = (const float*)(F.ws + SM_SW);
    bf16* XG = (bf16*)(F.ws + WS_XG);
    LAS float* xs = (LAS float*)(F.lds); LAS float* hs = xs + 16384;
    const int ntiles = TILEE[MAXTILE];
    for (int item = F.vcu; item < ntiles * 32; item += F.G) {
        const int e = TILEE[item >> 5], s0 = item * 8; const int nvalid = CNT[e] - (s0 - CNT[32 + e]);
        if (nvalid <= 0) continue;
        for (int idx = F.tid; idx < 16384; idx += 512) { const int r = idx >> 11, d = idx & 2047; xs[d * 8 + r] = (r < nvalid) ? bf2f(XG[(size_t)(s0 + r) * DM + d]) : 0.f; }
        __syncthreads();
        const float* Wg = F.in[IN_W_GATE] + (size_t)e * DM * 512 + F.tid; const float* Wu = F.in[IN_W_UP] + (size_t)e * DM * 512 + F.tid;
        float ag[8], au[8];
#pragma unroll
        for (int r = 0; r < 8; ++r) { ag[r] = 0.f; au[r] = 0.f; }
        for (int d = 0; d < DM; ++d) { const float wgv = Wg[(size_t)d * 512], wuv = Wu[(size_t)d * 512]; const f32x4 x0 = *(const LAS f32x4*)(xs + d * 8), x1 = *(const LAS f32x4*)(xs + d * 8 + 4);
#pragma unroll
            for (int r = 0; r < 4; ++r) { ag[r] += x0[r] * wgv; au[r] += x0[r] * wuv; ag[4 + r] += x1[r] * wgv; au[4 + r] += x1[r] * wuv; } }
#pragma unroll
        for (int r = 0; r < 8; ++r) hs[F.tid * 8 + r] = (ag[r] / (1.0f + __expf(-ag[r]))) * au[r];
        __syncthreads();
        const float* Wd = F.in[IN_W_DOWN] + (size_t)e * 512 * DM + F.tid;
        float acc[4][8];
#pragma unroll
        for (int i = 0; i < 4; ++i)
#pragma unroll
            for (int r = 0; r < 8; ++r) acc[i][r] = 0.f;
        for (int j = 0; j < 512; ++j) { const f32x4 h0 = *(const LAS f32x4*)(hs + j * 8), h1 = *(const LAS f32x4*)(hs + j * 8 + 4);
#pragma unroll
            for (int i = 0; i < 4; ++i) { const float w = Wd[(size_t)j * DM + 512 * i];
#pragma unroll
                for (int r = 0; r < 4; ++r) { acc[i][r] += h0[r] * w; acc[i][4 + r] += h1[r] * w; } } }
#pragma unroll
        for (int r = 0; r < 8; ++r) if (r < nvalid) { const float w = SW[s0 + r];
#pragma unroll
            for (int i = 0; i < 4; ++i) XG[(size_t)(s0 + r) * DM + F.tid + 512 * i] = (bf16)f2bf(acc[i][r] * w); }
        __syncthreads();
    }
}
__device__ __forceinline__ void p10_final(Frame& F) {
    const int* TSLOT = (const int*)(F.ws + SM_TSLOT); const bf16* YD = (const bf16*)(F.ws + WS_XG); const float* gain = F.in[IN_FINAL_NORM];
    const int gw = F.vcu * NWAVES + F.wave, NGW = F.G * NWAVES;
    for (int rep = (DUP == 100 ? 0 : 1); rep < 2; ++rep)
    for (int tok = gw; tok < NTOK; tok += NGW) {
        const int s0 = TSLOT[tok * 2], s1 = TSLOT[tok * 2 + 1];
        f32x4* xr = (f32x4*)(F.out + (size_t)tok * DM) + F.lane; const f32x4* gr = (const f32x4*)gain + F.lane;
        const v2u* y0 = (const v2u*)(YD + (size_t)s0 * DM) + F.lane; const v2u* y1 = (const v2u*)(YD + (size_t)s1 * DM) + F.lane;
        f32x4 v[8]; float s = 0.f;
#pragma unroll
        for (int j = 0; j < 8; ++j) { v[j] = xr[64 * j]; const v2u a = y0[64 * j], b = y1[64 * j];
            v[j].x = (v[j].x + bflo(a.x)) + bflo(b.x); v[j].y = (v[j].y + bfhi(a.x)) + bfhi(b.x); v[j].z = (v[j].z + bflo(a.y)) + bflo(b.y); v[j].w = (v[j].w + bfhi(a.y)) + bfhi(b.y);
            s += (v[j].x * v[j].x + v[j].y * v[j].y) + (v[j].z * v[j].z + v[j].w * v[j].w); }
        const float rstd = 1.0f / sqrtf(wave_sum(s) * (1.f / DM) + EPS);
#pragma unroll
        for (int j = 0; j < 8; ++j) { const f32x4 g = gr[64 * j]; if (rep == 1 || rstd == 12345.678f) xr[64 * j] = (f32x4){v[j].x * rstd * g.x, v[j].y * rstd * g.y, v[j].z * rstd * g.z, v[j].w * rstd * g.w}; }
    }
}

constexpr int N_PHASES = 11;
struct Args { const float* in[22]; float* out; unsigned char* ws; int ph_lo, ph_hi; };
__global__ void __launch_bounds__(NWAVES * 64, 2) fwd(Args args) {
    extern __shared__ __attribute__((aligned(16))) unsigned char lds[];
    Frame F;
    F.lds = (LAS unsigned char*)lds;
    F.MISC = (volatile LAS unsigned*)(F.lds + MISC_OFF);
    F.tid = threadIdx.x; F.lane = F.tid & 63; F.wave = __builtin_amdgcn_readfirstlane(F.tid >> 6);
    F.G = gridDim.x; { const int bx = blockIdx.x; F.vcu = (F.G % 8 == 0) ? (bx % 8) * (F.G / 8) + bx / 8 : bx; }
#pragma unroll
    for (int i = 0; i < 22; ++i) F.in[i] = args.in[i];
    F.out = args.out; F.ws = args.ws; F.ctl = (gu32*)(args.ws + WS_CTL);
    for (int u = F.tid; u < (LDS_BYTES - LDSCTL_OFF) / 4; u += NWAVES * 64) ((LAS unsigned*)(F.lds + LDSCTL_OFF))[u] = 0u;
    __syncthreads();
    const int lo = args.ph_lo, hi = args.ph_hi;
    const bool multi = (hi - lo) > 1;
    XcdBarrier bar; bar.bar = (unsigned*)(F.ctl + CW_BAR); bar.x = 0; bar.st = nullptr;
    if (multi) bar = xcd_barrier_post((unsigned*)(F.ctl + CW_BAR), F.MISC + 8);
#define IN(k) (((PHMASK >> (k)) & 1) && lo <= (k) && (k) < hi)
#define SEAM(k) do { if (IN(k) && IN((k) + 1)) xcd_barrier(bar); } while (0)
    if (IN(0)) { p0_prologue(F); if (DUP == 0) { __syncthreads(); p0_prologue(F); } } SEAM(0);
    if (IN(1)) {
        pg8::Gemm g{DM, DM * 2, DM * 2, 128}; pg8::DenseOrder S; S.init(F.ws + WS_B, F.ws + WS_WINT, NTOK, LDP, DM * 2, DM * 2, F.G, (int)blockIdx.x);
        pg8::EpiBf16<0> E{(pg8::bf16_t*)(F.ws + WS_PROJ), LDP, nullptr};
        pg8::gemm_phase<pg8::EpiBf16<0>, pg8::DenseOrder, true, true>(F.lds + RING_OFF, g, S, E);
        if (DUP == 1) { __syncthreads(); pg8::gemm_phase<pg8::EpiBf16<0>, pg8::DenseOrder, true, true>(F.lds + RING_OFF, g, S, E); }
    } SEAM(1);
#if NAIVE_HGRN
    if (IN(2)) { n2_rope_compress(F); } SEAM(2);
    if (IN(3)) { n3_mixers(F); } SEAM(3);
    if (IN(4)) { n4_nsanorm(F); } SEAM(4);
#else
    if (IN(2)) {
#if !NAIVE_CMP
        if (F.vcu < 32) {
            const int br = F.vcu >> 4; const float* BP = (const float*)(F.ws + SM_BPART) + br * 32 * 256;
            if (F.tid < 256) { float s = 0.f;
#pragma unroll 8
                for (int ch = 0; ch < 32; ++ch) s += BP[ch * 256 + F.tid];
                ((float*)(F.ws + (br ? SM_B1V : SM_B1K)))[F.tid] = s; }
            VM_WAIT(); __syncthreads(); }
        {
            pg8::Gemm g{DM, 16 * LDP * 2, DM * 2, LDP * 2}; pg8::CmpOrder S{F.vcu, (const char*)(F.ws + WS_PROJ), (const char*)(F.ws + SM_W1KT), (const char*)(F.ws + SM_W1VT), (size_t)LDP * 2, C_KC * 2, C_VC * 2};
            pg8::EpiCmp E{(pg8::bf16_t*)(F.ws + WS_HIDC), (const float*)(F.ws + SM_B1K), (const float*)(F.ws + SM_B1V)};
            pg8::gemm_phase<pg8::EpiCmp, pg8::CmpOrder, true, true>(F.lds + RING_OFF, g, S, E);
            __syncthreads();
            if (DUP == 20) { pg8::gemm_phase<pg8::EpiCmp, pg8::CmpOrder, true, true>(F.lds + RING_OFF, g, S, E); __syncthreads(); }
        }
#endif
        if (DUP == 21) hgrn_passA<false>(F);
        hgrn_passA<true>(F); n2_rope_compress(F); } SEAM(2);
#if NAIVE_ATTN
    if (IN(3)) { hgrn_scan(F); n3_mixers(F); } SEAM(3);
#else
    if (IN(3)) { hgrn_scan(F); if (DUP == 30) hgrn_scan(F); attn_phase<0>(F); if (DUP == 3) { __syncthreads(); attn_phase<0>(F); } if (DUP == 34) { __syncthreads(); attn_phase<4>(F); } if (DUP == 35) { __syncthreads(); attn_phase<5>(F); } } SEAM(3);
#endif
    if (IN(4)) { hgrn_passB(F); n4_nsanorm(F); if (DUP == 4) { __syncthreads(); hgrn_passB(F); n4_nsanorm(F); } } SEAM(4);
#endif
    if (IN(5)) {
        pg8::Gemm g{DM, DM * 2, DM * 2, 128}; pg8::DenseOrder S; S.init(F.ws + WS_B, F.ws + WS_WOT, NTOK, DM, DM * 2, DM * 2, F.G, (int)blockIdx.x);
        pg8::EpiResF32 E{F.in[IN_X], F.out, DM};
        pg8::gemm_phase<pg8::EpiResF32, pg8::DenseOrder, true, true>(F.lds + RING_OFF, g, S, E);
        if (DUP == 5) { __syncthreads(); pg8::gemm_phase<pg8::EpiResF32, pg8::DenseOrder, true, true>(F.lds + RING_OFF, g, S, E); }
    } SEAM(5);
    if (IN(6)) { p6_router(F); }
    do { if (IN(6) && IN(8)) xcd_barrier(bar); } while (0);
#if NAIVE_MOE
    if (IN(8)) { n8_moe(F); } SEAM(8); SEAM(9);
#else
    if (IN(8)) {
        const int* TILEE = (const int*)(F.ws + SM_TILEE);
        pg8::Gemm g{DM, DM * 2, DM * 2, 128}; pg8::MoeOrder S; S.init(F.ws + WS_XG, F.ws + WS_WGUT, TILEE, (int)__hip_atomic_load(F.ctl + CW_NT, RLX_AGENT), 4, DM * 2, DM * 2, 1024, F.G, F.vcu);
        pg8::EpiSwiGLU E{(pg8::bf16_t*)(F.ws + WS_HIDM), 512, (const float*)(F.ws + SM_SRS)};
        pg8::gemm_phase<pg8::EpiSwiGLU, pg8::MoeOrder, true, true>(F.lds + RING_OFF, g, S, E);
        if (DUP == 8) { __syncthreads(); pg8::gemm_phase<pg8::EpiSwiGLU, pg8::MoeOrder, true, true>(F.lds + RING_OFF, g, S, E); }
    } SEAM(8);
    if (IN(9)) {
        const int* TILEE = (const int*)(F.ws + SM_TILEE);
        pg8::Gemm g{512, 512 * 2, 512 * 2, 128}; pg8::MoeOrder S; S.init(F.ws + WS_HIDM, F.ws + WS_WDT, TILEE, (int)__hip_atomic_load(F.ctl + CW_NT, RLX_AGENT), 8, 512 * 2, 512 * 2, DM, F.G, F.vcu);
        pg8::EpiRowScaleBf16 E{(pg8::bf16_t*)(F.ws + WS_XG), DM, (const float*)(F.ws + SM_SW)};
        pg8::gemm_phase<pg8::EpiRowScaleBf16, pg8::MoeOrder, true, true>(F.lds + RING_OFF, g, S, E);
        if (DUP == 9) { __syncthreads(); pg8::gemm_phase<pg8::EpiRowScaleBf16, pg8::MoeOrder, true, true>(F.lds + RING_OFF, g, S, E); }
    } SEAM(9);
#endif
    if (IN(10)) { p10_final(F); }
    if (DUP == 99 && multi) { xcd_barrier(bar); xcd_barrier(bar); xcd_barrier(bar); xcd_barrier(bar); }
#undef IN
#undef SEAM
}

extern "C" void kernel_launch(void* const* d_in, const int* in_sizes, int n_in, void* d_out, int out_size, void* d_ws, size_t ws_size, hipStream_t stream) {
    static int grid = 0;
    if (grid == 0) {
        if (n_in != 22 || out_size != NTOK * DM || ws_size < WS_END) { fprintf(stderr, "kernel_launch: unexpected shapes (n_in %d, out %d, ws %zu < %zu)\n", n_in, out_size, ws_size, (size_t)WS_END); grid = -1; return; }
        int dev = 0, cus = 0, per_cu = 0;
        if (hipGetDevice(&dev) != hipSuccess || hipDeviceGetAttribute(&cus, hipDeviceAttributeMultiprocessorCount, dev) != hipSuccess) { grid = -1; return; }
        if (hipFuncSetAttribute((const void*)fwd, hipFuncAttributeMaxDynamicSharedMemorySize, LDS_BYTES) != hipSuccess) { fprintf(stderr, "kernel_launch: hipFuncSetAttribute failed\n"); grid = -1; return; }
        if (hipOccupancyMaxActiveBlocksPerMultiprocessor(&per_cu, (const void*)fwd, NWAVES * 64, LDS_BYTES) != hipSuccess || per_cu < 1) { fprintf(stderr, "kernel_launch: occupancy query says %d\n", per_cu); }
        (void)hipGetLastError();
        grid = cus;
    }
    if (grid < 0) return;
    (void)hipMemsetAsync((char*)d_ws + WS_CTL, 0, CTL_ZERO_BYTES, stream);
    Args a{};
    for (int i = 0; i < 22; ++i) a.in[i] = (const float*)d_in[i];
    a.out = (float*)d_out; a.ws = (unsigned char*)d_ws;
#if MK_ONE_LAUNCH
    a.ph_lo = 0; a.ph_hi = N_PHASES;
    hipLaunchKernelGGL(fwd, dim3(grid), dim3(NWAVES * 64), LDS_BYTES, stream, a);
#else
    for (int p = 0; p < N_PHASES; ++p) { a.ph_lo = p; a.ph_hi = p + 1; hipLaunchKernelGGL(fwd, dim3(grid), dim3(NWAVES * 64), LDS_BYTES, stream, a); }
#endif
}
```
